# Optimizing an MI355X kernel written in HIP

```python
import jax, jax.numpy as jnp
from jax import lax
import numpy as np

D_MODEL = 1024
BATCH = 8
SEQ = 2048
DEPTH = 4

CHUNK = 64
N_MIXERS = 3
N_GLA = (DEPTH + 2) // 3
N_MLA = (DEPTH + 1) // 3
N_CONV = DEPTH // 3
ALPHA = (2 * DEPTH) ** 0.25
BETA = (8 * DEPTH) ** -0.25
LN_EPS = 1e-5
RMS_EPS = 1e-6
PLE_DIM = 256
D_FF = 4 * D_MODEL
MAX_OFFSET = 4096

GLA_HEADS = 4
GLA_DK = D_MODEL // 2 // GLA_HEADS
GLA_DV = D_MODEL // GLA_HEADS
GLA_GATE_RANK = 16
GLA_TAU = 16.0
GLA_HK = GLA_HEADS * GLA_DK
GLA_HV = GLA_HEADS * GLA_DV
GLA_SPLITS = [GLA_HK, 2 * GLA_HK, 2 * GLA_HK + GLA_HV, 2 * GLA_HK + GLA_HV + D_MODEL]
GLA_IN = 2 * GLA_HK + GLA_HV + D_MODEL + GLA_GATE_RANK

MLA_HEADS = 8
MLA_NOPE = 128
MLA_ROPE = 64
MLA_V = 128
MLA_Q_RANK = 256
MLA_KV_RANK = 256
MLA_IN = MLA_Q_RANK + MLA_KV_RANK + MLA_ROPE
ROPE_BASE = 10000.0
Q_BLOCK = 128

CONV_WIDTH = 3

kernel_name = 'hybrid_gla_mla_shortconv_deepnorm_trunk'


def layer_norm(x, g, b):
    xf = x.astype(jnp.float32)
    mu = jnp.mean(xf, -1, keepdims=True)
    var = jnp.mean(jnp.square(xf - mu), -1, keepdims=True)
    return ((xf - mu) * lax.rsqrt(var + LN_EPS) * g + b).astype(x.dtype)


def rms_norm(x, g):
    xf = x.astype(jnp.float32)
    return (xf * lax.rsqrt(jnp.mean(xf * xf, -1, keepdims=True) + RMS_EPS) * g).astype(x.dtype)


def rope(x, cos, sin):
    x1, x2 = jnp.split(x, 2, axis=-1)
    return jnp.concatenate([x1 * cos - x2 * sin, x2 * cos + x1 * sin], axis=-1)


def gla_mixer(x, w_in, w_gate_up, b_gate, norm_g, w_out):
    B_, S_, _ = x.shape
    nc = S_ // CHUNK
    q, k, v, r, g_lr = jnp.split(x @ w_in, GLA_SPLITS, axis=-1)
    log_a = jax.nn.log_sigmoid((g_lr @ w_gate_up + b_gate).astype(jnp.float32)) / GLA_TAU

    def to_chunks(t, d):
        return t.astype(jnp.float32).reshape(B_, nc, CHUNK, GLA_HEADS, d).transpose(1, 0, 3, 2, 4)

    qc = to_chunks(q, GLA_DK) * GLA_DK ** -0.5
    kc = to_chunks(k, GLA_DK)
    vc = to_chunks(v, GLA_DV)
    lc = to_chunks(log_a, GLA_DK)

    def step(state, inp):
        q_, k_, v_, la = inp
        L = jnp.cumsum(la, axis=2)
        decay = jnp.exp(-jnp.abs(L[:, :, :, None, :] - L[:, :, None, :, :]))
        scores = jnp.einsum('bhtd,bhsd,bhtsd->bhts', q_, k_, decay)
        o = scores @ v_ + (q_ * jnp.exp(L)) @ state
        L_end = L[:, :, -1:, :]
        state = (jnp.exp(L_end[:, :, 0, :, None]) * state
                 + jnp.einsum('bhsd,bhse->bhde', k_ * jnp.exp(L_end - L), v_))
        return state, o

    s0 = jnp.zeros((B_, GLA_HEADS, GLA_DK, GLA_DV), jnp.float32)
    _, o = lax.scan(step, s0, (qc, kc, vc, lc))
    o = o.transpose(1, 0, 3, 2, 4).reshape(B_, S_, GLA_HEADS, GLA_DV)
    o = rms_norm(o, norm_g).reshape(B_, S_, GLA_HV) * jax.nn.silu(r.astype(jnp.float32))
    return o.astype(x.dtype) @ w_out


def mla_mixer(x, cos, sin, w_in, q_norm, kv_norm, w_uq, w_ukv, w_out):
    B_, S_, _ = x.shape
    c_q, c_kv, k_rope = jnp.split(x @ w_in, [MLA_Q_RANK, MLA_Q_RANK + MLA_KV_RANK], axis=-1)
    q = (rms_norm(c_q, q_norm) @ w_uq).reshape(B_, S_, MLA_HEADS, MLA_NOPE + MLA_ROPE)
    kv = (rms_norm(c_kv, kv_norm) @ w_ukv).reshape(B_, S_, MLA_HEADS, MLA_NOPE + MLA_V)
    q_nope, q_rope = jnp.split(q, [MLA_NOPE], axis=-1)
    k_nope, v = jnp.split(kv, [MLA_NOPE], axis=-1)
    q_rope = rope(q_rope, cos[:, :, None, :], sin[:, :, None, :])
    k_rope = rope(k_rope, cos, sin)
    qf = jnp.concatenate([q_nope.astype(jnp.float32), q_rope.astype(jnp.float32)], axis=-1)
    qf = qf * (MLA_NOPE + MLA_ROPE) ** -0.5
    kf = jnp.concatenate([k_nope.astype(jnp.float32),
                          jnp.broadcast_to(k_rope.astype(jnp.float32)[:, :, None, :],
                                           (B_, S_, MLA_HEADS, MLA_ROPE))], axis=-1)
    n_qb = S_ // Q_BLOCK
    q_blocks = qf.reshape(B_, n_qb, Q_BLOCK, MLA_HEADS, MLA_NOPE + MLA_ROPE).transpose(1, 0, 2, 3, 4)
    key_chunk = jnp.arange(S_) // CHUNK

    def attend(args):
        qb, bi = args
        q_chunk = (bi * Q_BLOCK + jnp.arange(Q_BLOCK)) // CHUNK
        s = jnp.einsum('bqhd,bkhd->bhqk', qb, kf)
        s = jnp.where(key_chunk[None, :] <= q_chunk[:, None], s, -jnp.inf)
        pr = jax.nn.softmax(s, axis=-1)
        return jnp.einsum('bhqk,bkhd->bqhd', pr.astype(v.dtype), v)

    o = lax.map(attend, (q_blocks, jnp.arange(n_qb)))
    o = o.transpose(1, 0, 2, 3, 4).reshape(B_, S_, MLA_HEADS * MLA_V)
    return o.astype(x.dtype) @ w_out


def conv_mixer(x, w_in, conv_w, w_out):
    b, c, u = jnp.split(x @ w_in, 3, axis=-1)
    z = lax.conv_general_dilated(c * u, conv_w[:, None, :], window_strides=(1,),
                                 padding=[(CONV_WIDTH - 1, 0)],
                                 dimension_numbers=('NWC', 'WIO', 'NWC'),
                                 feature_group_count=D_MODEL)
    return (b * z) @ w_out


def sq_relu_mlp(x, w1, w2):
    return jnp.square(jax.nn.relu(x @ w1)) @ w2


def setup_inputs(seed: int = 0) -> dict:
    key = jax.random.key(seed)
    ks = jax.random.split(key, 24)

    def nrm(i, shape, scale):
        return jax.random.normal(ks[i], shape, jnp.float32) * scale

    x = nrm(0, (BATCH, SEQ, D_MODEL), 1.0)
    p = nrm(1, (DEPTH, BATCH, SEQ, PLE_DIM), 1.0)
    offsets = jax.random.randint(ks[2], (BATCH, 1), 0, MAX_OFFSET, dtype=jnp.int32)
    positions = (offsets + jnp.arange(SEQ, dtype=jnp.int32)[None, :]).astype(jnp.int32)
    return {
        'x': x,
        'p': p,
        'positions': positions,
        'gla_w_in': nrm(3, (N_GLA, D_MODEL, GLA_IN), D_MODEL ** -0.5),
        'gla_w_gate_up': nrm(4, (N_GLA, GLA_GATE_RANK, GLA_HK), GLA_GATE_RANK ** -0.5),
        'gla_b_gate': nrm(5, (N_GLA, GLA_HK), 0.1),
        'gla_norm_g': 1.0 + nrm(6, (N_GLA, GLA_DV), 0.01),
        'gla_w_out': nrm(7, (N_GLA, GLA_HV, D_MODEL), GLA_HV ** -0.5 * BETA),
        'mla_w_in': nrm(8, (N_MLA, D_MODEL, MLA_IN), D_MODEL ** -0.5),
        'mla_q_norm': 1.0 + nrm(9, (N_MLA, MLA_Q_RANK), 0.01),
        'mla_kv_norm': 1.0 + nrm(10, (N_MLA, MLA_KV_RANK), 0.01),
        'mla_w_uq': nrm(11, (N_MLA, MLA_Q_RANK, MLA_HEADS * (MLA_NOPE + MLA_ROPE)), MLA_Q_RANK ** -0.5),
        'mla_w_ukv': nrm(12, (N_MLA, MLA_KV_RANK, MLA_HEADS * (MLA_NOPE + MLA_V)), MLA_KV_RANK ** -0.5),
        'mla_w_out': nrm(13, (N_MLA, MLA_HEADS * MLA_V, D_MODEL), (MLA_HEADS * MLA_V) ** -0.5 * BETA),
        'conv_w_in': nrm(14, (N_CONV, D_MODEL, 3 * D_MODEL), D_MODEL ** -0.5),
        'conv_w': nrm(15, (N_CONV, CONV_WIDTH, D_MODEL), CONV_WIDTH ** -0.5),
        'conv_w_out': nrm(16, (N_CONV, D_MODEL, D_MODEL), D_MODEL ** -0.5 * BETA),
        'ln_g': 1.0 + nrm(17, (DEPTH, 2, D_MODEL), 0.01),
        'ln_b': nrm(18, (DEPTH, 2, D_MODEL), 0.01),
        'mlp_w1': nrm(19, (DEPTH, D_MODEL, D_FF), D_MODEL ** -0.5),
        'mlp_w2': nrm(20, (DEPTH, D_FF, D_MODEL), D_FF ** -0.5 * BETA),
        'ple_w_gate': nrm(21, (DEPTH, D_MODEL, D_MODEL), D_MODEL ** -0.5),
        'ple_w_proj': nrm(22, (DEPTH, PLE_DIM, D_MODEL), PLE_DIM ** -0.5),
    }


def reference(x, p, positions, gla_w_in, gla_w_gate_up, gla_b_gate, gla_norm_g, gla_w_out,
              mla_w_in, mla_q_norm, mla_kv_norm, mla_w_uq, mla_w_ukv, mla_w_out,
              conv_w_in, conv_w, conv_w_out, ln_g, ln_b, mlp_w1, mlp_w2,
              ple_w_gate, ple_w_proj):
    inv_freq = ROPE_BASE ** (-jnp.arange(0, MLA_ROPE // 2, dtype=jnp.float32) * (2.0 / MLA_ROPE))
    ang = positions.astype(jnp.float32)[..., None] * inv_freq
    cos, sin = jnp.cos(ang), jnp.sin(ang)
    for i in range(DEPTH):
        j = i // N_MIXERS
        kind = i % N_MIXERS
        if kind == 0:
            h = gla_mixer(x, gla_w_in[j], gla_w_gate_up[j], gla_b_gate[j], gla_norm_g[j], gla_w_out[j])
        elif kind == 1:
            h = mla_mixer(x, cos, sin, mla_w_in[j], mla_q_norm[j], mla_kv_norm[j],
                          mla_w_uq[j], mla_w_ukv[j], mla_w_out[j])
        else:
            h = conv_mixer(x, conv_w_in[j], conv_w[j], conv_w_out[j])
        x = layer_norm(ALPHA * x + h, ln_g[i, 0], ln_b[i, 0])
        x = layer_norm(ALPHA * x + sq_relu_mlp(x, mlp_w1[i], mlp_w2[i]), ln_g[i, 1], ln_b[i, 1])
        x = x + jax.nn.sigmoid(x @ ple_w_gate[i]) * (p[i] @ ple_w_proj[i])
    return x
```

```cpp
#include <hip/hip_runtime.h>
#include <cstdint>
#include <cstdio>

namespace {
constexpr int NB = 8, S = 2048, D = 1024, M = NB * S, DEPTH = 4, CH = 64, NCH = S / CH;
constexpr int FF = 4096, PLE = 256;
constexpr int GLA_IN = 3088, GH = 4, GDK = 128, GDV = 256, GHK = 512, GHV = 1024, GRANK = 16;
constexpr int MLA_IN = 576, MH = 8, MNOPE = 128, MROPE = 64, MV = 128, MQK = 192;
constexpr float ALPHA = 1.6817928305074290860622509524664f;
constexpr float LN_EPS = 1e-5f, RMS_EPS = 1e-6f;

typedef unsigned short bf16_t;
__device__ __forceinline__ float ldf(const float* p, size_t i) { return p[i]; }
__device__ __forceinline__ float ldf(const bf16_t* p, size_t i) { return __uint_as_float(((unsigned)p[i]) << 16); }
__device__ __forceinline__ unsigned f2bf(float f) { unsigned u = __float_as_uint(f); return (u + 0x7fffu + ((u >> 16) & 1u)) >> 16; }
__device__ __forceinline__ void stf(float* p, size_t i, float v) { p[i] = v; }
__device__ __forceinline__ void stf(bf16_t* p, size_t i, float v) { p[i] = (bf16_t)f2bf(v); }
__device__ __forceinline__ float wave_sum(float v) {
#pragma unroll
    for (int o = 1; o < 64; o <<= 1) v += __shfl_xor(v, o);
    return v;
}
__device__ __forceinline__ float wave_max(float v) {
#pragma unroll
    for (int o = 1; o < 64; o <<= 1) v = fmaxf(v, __shfl_xor(v, o));
    return v;
}
__device__ __forceinline__ float log_sigmoid(float z) { return fminf(z, 0.f) - log1pf(expf(-fabsf(z))); }
__device__ __forceinline__ float sigmoidf_(float z) { return 1.f / (1.f + expf(-z)); }
__device__ __forceinline__ float inv_freq(int j) { return (float)exp2(-(double)j * (1.0 / 32.0) * 13.287712379549449); }

template <int EPI>
__global__ __launch_bounds__(256) void k_gemm(const float* __restrict__ A, int lda, const float* __restrict__ W, int ldw, float* __restrict__ C, int ldc, int Mr, int N, int K) {
    __shared__ float As[16][132];
    __shared__ float Bs[16][132];
    const int t = threadIdx.x, tx = t & 15, ty = t >> 4;
    const int row0 = blockIdx.y * 128, col0 = blockIdx.x * 128;
    float acc[8][8];
#pragma unroll
    for (int i = 0; i < 8; ++i)
#pragma unroll
        for (int j = 0; j < 8; ++j) acc[i][j] = 0.f;
    for (int k0 = 0; k0 < K; k0 += 16) {
#pragma unroll
        for (int i = 0; i < 8; ++i) { const int idx = t + i * 256, r = idx >> 4, kk = idx & 15; As[kk][r] = A[(size_t)(row0 + r) * lda + k0 + kk]; }
#pragma unroll
        for (int i = 0; i < 8; ++i) { const int idx = t + i * 256, kk = idx >> 7, c = idx & 127; Bs[kk][c] = (col0 + c < N) ? W[(size_t)(k0 + kk) * ldw + col0 + c] : 0.f; }
        __syncthreads();
#pragma unroll
        for (int kk = 0; kk < 16; ++kk) {
            float a[8], b[8];
#pragma unroll
            for (int i = 0; i < 4; ++i) { a[i] = As[kk][ty * 4 + i]; a[4 + i] = As[kk][64 + ty * 4 + i]; b[i] = Bs[kk][tx * 4 + i]; b[4 + i] = Bs[kk][64 + tx * 4 + i]; }
#pragma unroll
            for (int i = 0; i < 8; ++i)
#pragma unroll
                for (int j = 0; j < 8; ++j) acc[i][j] += a[i] * b[j];
        }
        __syncthreads();
    }
#pragma unroll
    for (int i = 0; i < 8; ++i) {
        const int r = row0 + (i < 4 ? ty * 4 + i : 64 + ty * 4 + i - 4);
#pragma unroll
        for (int j = 0; j < 8; ++j) {
            const int c = col0 + (j < 4 ? tx * 4 + j : 64 + tx * 4 + j - 4);
            float v = acc[i][j];
            if (EPI == 1) { v = fmaxf(v, 0.f); v = v * v; }
            if (c < N && r < Mr) C[(size_t)r * ldc + c] = v;
        }
    }
}

#define GSTRIDE(i, n) for (size_t i = (size_t)blockIdx.x * blockDim.x + threadIdx.x; i < (size_t)(n); i += (size_t)gridDim.x * blockDim.x)

template <class T> __device__ __forceinline__ void gla_L(const T* glr, int ldg, const float* wgu, const float* bg, float* L, int Mloc) {
    GSTRIDE(idx, (size_t)(Mloc / CH) * GHK) {
        const int ch = (int)(idx % GHK); const int cn = (int)(idx / GHK);
        float acc = 0.f;
        for (int t = 0; t < CH; ++t) {
            const size_t m = (size_t)cn * CH + t; float z = bg[ch];
            for (int r = 0; r < GRANK; ++r) z += ldf(glr, m * ldg + r) * wgu[r * GHK + ch];
            acc += log_sigmoid(z) * (1.f / 16.f);
            L[m * GHK + ch] = acc;
        }
    }
}
template <class T> __device__ __forceinline__ void gla_state(const T* k, int ldk, const T* v, int ldv, const float* L, float* ST, int nb) {
    GSTRIDE(idx, (size_t)nb * GH * GDK * GDV) {
        const int dv = (int)(idx % GDV), dk = (int)((idx / GDV) % GDK), h = (int)((idx / (GDV * GDK)) % GH), b = (int)(idx / ((size_t)GDV * GDK * GH));
        float st = 0.f;
        for (int n = 0; n < NCH; ++n) {
            ST[(((size_t)(b * GH + h) * NCH + n) * GDK + dk) * GDV + dv] = st;
            const size_t m0 = (size_t)b * S + n * CH;
            const float Lend = L[(m0 + CH - 1) * GHK + h * GDK + dk];
            float acc = 0.f;
            for (int s = 0; s < CH; ++s) { const size_t m = m0 + s; acc += ldf(k, m * ldk + h * GDK + dk) * expf(Lend - L[m * GHK + h * GDK + dk]) * ldf(v, m * ldv + h * GDV + dv); }
            st = expf(Lend) * st + acc;
        }
    }
}
template <class T> __device__ __forceinline__ void gla_scores(const T* q, int ldq, const T* k, int ldk, const float* L, float* SC, int nb) {
    GSTRIDE(idx, (size_t)nb * GH * NCH * CH * CH) {
        const int s = (int)(idx % CH), t = (int)((idx / CH) % CH); const size_t unit = idx / (CH * CH);
        const int n = (int)(unit % NCH), h = (int)((unit / NCH) % GH), b = (int)(unit / (NCH * GH));
        const size_t mt = (size_t)b * S + n * CH + t, ms = (size_t)b * S + n * CH + s;
        float acc = 0.f;
        for (int d = 0; d < GDK; ++d) acc += ldf(q, mt * ldq + h * GDK + d) * ldf(k, ms * ldk + h * GDK + d) * expf(-fabsf(L[mt * GHK + h * GDK + d] - L[ms * GHK + h * GDK + d]));
        SC[idx] = acc * 0.088388347648318440550f;
    }
}
template <class T> __device__ __forceinline__ void gla_out(const T* q, int ldq, const T* v, int ldv, const float* L, const float* SC, const float* ST, float* O, int nb) {
    GSTRIDE(idx, (size_t)nb * S * GH * GDV) {
        const int dv = (int)(idx % GDV), h = (int)((idx / GDV) % GH); const size_t m = idx / (GDV * GH);
        const int b = (int)(m / S), tt = (int)(m % S), n = tt / CH, t = tt % CH;
        const size_t unit = (size_t)(b * GH + h) * NCH + n, m0 = (size_t)b * S + n * CH;
        float acc = 0.f;
        for (int s = 0; s < CH; ++s) acc += SC[(unit * CH + t) * CH + s] * ldf(v, (m0 + s) * ldv + h * GDV + dv);
        float acc2 = 0.f;
        for (int dk = 0; dk < GDK; ++dk) acc2 += ldf(q, m * ldq + h * GDK + dk) * expf(L[m * GHK + h * GDK + dk]) * ST[(unit * GDK + dk) * GDV + dv];
        O[m * GHV + h * GDV + dv] = acc + acc2 * 0.088388347648318440550f;
    }
}
template <class T, class TO> __device__ __forceinline__ void gla_norm(const float* O, const T* r, int ldr, const float* g, TO* OG, int Mloc) {
    const int lane = threadIdx.x & 63; const size_t gw = ((size_t)blockIdx.x * blockDim.x + threadIdx.x) >> 6, nw = ((size_t)gridDim.x * blockDim.x) >> 6;
    for (size_t it = gw; it < (size_t)Mloc * GH; it += nw) {
        const size_t m = it / GH; const int h = (int)(it % GH);
        float o[4], ss = 0.f;
#pragma unroll
        for (int j = 0; j < 4; ++j) { o[j] = O[m * GHV + h * GDV + lane + 64 * j]; ss += o[j] * o[j]; }
        const float rstd = rsqrtf(wave_sum(ss) * (1.f / GDV) + RMS_EPS);
#pragma unroll
        for (int j = 0; j < 4; ++j) { const int dv = lane + 64 * j; const float rv = ldf(r, m * ldr + h * GDV + dv); stf(OG, m * GHV + h * GDV + dv, o[j] * rstd * g[dv] * (rv * sigmoidf_(rv))); }
    }
}
template <class TO> __device__ __forceinline__ void res_ln(const float* x, const float* h, const float* g, const float* b, float* out, TO* outb, int Mloc) {
    const int lane = threadIdx.x & 63; const size_t gw = ((size_t)blockIdx.x * blockDim.x + threadIdx.x) >> 6, nw = ((size_t)gridDim.x * blockDim.x) >> 6;
    for (size_t m = gw; m < (size_t)Mloc; m += nw) {
        float y[16], s = 0.f;
#pragma unroll
        for (int j = 0; j < 16; ++j) { const int c = lane + 64 * j; y[j] = ALPHA * x[m * D + c] + h[m * D + c]; s += y[j]; }
        const float mu = wave_sum(s) * (1.f / D); float q = 0.f;
#pragma unroll
        for (int j = 0; j < 16; ++j) { y[j] -= mu; q += y[j] * y[j]; }
        const float rstd = rsqrtf(wave_sum(q) * (1.f / D) + LN_EPS);
#pragma unroll
        for (int j = 0; j < 16; ++j) { const int c = lane + 64 * j; const float o = y[j] * rstd * g[c] + b[c]; out[m * D + c] = o; if (outb) stf(outb, m * D + c, o); }
    }
}
__device__ __forceinline__ void ple_elt(const float* x2, const float* G, const float* P, float* x3, size_t n) {
    GSTRIDE(i, n) x3[i] = x2[i] + sigmoidf_(G[i]) * P[i];
}
template <class T, class TO> __device__ __forceinline__ void mla_prep(const T* Cb, int ldc, const float* qn, const float* kvn, const int* pos, TO* cqn, TO* ckvn, TO* kr, int Mloc) {
    const int lane = threadIdx.x & 63; const size_t gw = ((size_t)blockIdx.x * blockDim.x + threadIdx.x) >> 6, nw = ((size_t)gridDim.x * blockDim.x) >> 6;
    for (size_t m = gw; m < (size_t)Mloc; m += nw) {
        float a[4], c[4], sa = 0.f, sc = 0.f;
#pragma unroll
        for (int j = 0; j < 4; ++j) { a[j] = ldf(Cb, m * ldc + lane + 64 * j); c[j] = ldf(Cb, m * ldc + 256 + lane + 64 * j); sa += a[j] * a[j]; sc += c[j] * c[j]; }
        const float ra = rsqrtf(wave_sum(sa) * (1.f / 256.f) + RMS_EPS), rc = rsqrtf(wave_sum(sc) * (1.f / 256.f) + RMS_EPS);
#pragma unroll
        for (int j = 0; j < 4; ++j) { const int d = lane + 64 * j; stf(cqn, m * 256 + d, a[j] * ra * qn[d]); stf(ckvn, m * 256 + d, c[j] * rc * kvn[d]); }
        if (lane < 32) {
            const float x1 = ldf(Cb, m * ldc + 512 + lane), x2 = ldf(Cb, m * ldc + 544 + lane);
            const float ang = (float)pos[m] * inv_freq(lane); const float cs = (float)cos((double)ang), sn = (float)sin((double)ang);
            stf(kr, m * 64 + lane, x1 * cs - x2 * sn); stf(kr, m * 64 + 32 + lane, x2 * cs + x1 * sn);
        }
    }
}
template <class T> __device__ __forceinline__ void mla_qrope(T* q, const int* pos, int Mloc) {
    GSTRIDE(idx, (size_t)Mloc * MH * 32) {
        const int j = (int)(idx % 32), h = (int)((idx / 32) % MH); const size_t m = idx / (32 * MH);
        const size_t o = m * (MH * MQK) + h * MQK + MNOPE + j;
        const float x1 = ldf(q, o), x2 = ldf(q, o + 32);
        const float ang = (float)pos[m] * inv_freq(j); const float cs = (float)cos((double)ang), sn = (float)sin((double)ang);
        stf(q, o, x1 * cs - x2 * sn); stf(q, o + 32, x2 * cs + x1 * sn);
    }
}
template <class T, class TO> __device__ __forceinline__ void mla_attn(const T* q, const T* kv, const T* kr, TO* o, int nb, float* sc) {
    const int lane = threadIdx.x & 63; const size_t gw = ((size_t)blockIdx.x * blockDim.x + threadIdx.x) >> 6, nw = ((size_t)gridDim.x * blockDim.x) >> 6;
    for (size_t it = gw; it < (size_t)nb * MH * S; it += nw) {
        const int qi = (int)(it % S), h = (int)((it / S) % MH), b = (int)(it / ((size_t)S * MH));
        const size_t m = (size_t)b * S + qi; const int lim = (qi / CH + 1) * CH;
        const T* qp = q + m * (MH * MQK) + h * MQK;
        float mx = -INFINITY;
        for (int s = lane; s < lim; s += 64) {
            const size_t ms = (size_t)b * S + s; const T* kp = kv + ms * (MH * 256) + h * 256; const T* rp = kr + ms * 64;
            float dot = 0.f;
            for (int d = 0; d < MNOPE; ++d) dot += ldf(qp, d) * ldf(kp, d);
            for (int j = 0; j < MROPE; ++j) dot += ldf(qp, MNOPE + j) * ldf(rp, j);
            dot *= 0.072168783648703220564f;
            sc[s] = dot; mx = fmaxf(mx, dot);
        }
        mx = wave_max(mx);
        float sum = 0.f;
        for (int s = lane; s < lim; s += 64) { const float p = expf(sc[s] - mx); sc[s] = p; sum += p; }
        sum = wave_sum(sum);
        __builtin_amdgcn_s_waitcnt(0); __builtin_amdgcn_wave_barrier();
        float a0 = 0.f, a1 = 0.f;
        for (int s = 0; s < lim; ++s) { const size_t ms = (size_t)b * S + s; const float p = sc[s]; a0 += p * ldf(kv, ms * (MH * 256) + h * 256 + 128 + lane); a1 += p * ldf(kv, ms * (MH * 256) + h * 256 + 192 + lane); }
        const float inv = 1.f / sum;
        stf(o, m * (MH * MV) + h * MV + lane, a0 * inv); stf(o, m * (MH * MV) + h * MV + 64 + lane, a1 * inv);
        __builtin_amdgcn_s_waitcnt(0); __builtin_amdgcn_wave_barrier();
    }
}
template <class T, class TO> __device__ __forceinline__ void conv_mix(const T* bcu, int ld, const float* cw, TO* a, int Mloc) {
    GSTRIDE(idx, (size_t)Mloc * D) {
        const int c = (int)(idx % D); const size_t m = idx / D; const int t = (int)(m % S);
        float z = 0.f;
#pragma unroll
        for (int j = 0; j < 3; ++j) { const int dt = 2 - j; if (t - dt >= 0) { const size_t mm = m - dt; z += cw[j * D + c] * ldf(bcu, mm * ld + D + c) * ldf(bcu, mm * ld + 2 * D + c); } }
        stf(a, idx, ldf(bcu, m * ld + c) * z);
    }
}

struct P { const void* a[8]; void* o[4]; int i[8]; };
template <int PH> __global__ __launch_bounds__(256) void k_phase(P p) {
    __shared__ float sc[4 * S];
    if (PH == 0) gla_L<float>((const float*)p.a[0], p.i[0], (const float*)p.a[1], (const float*)p.a[2], (float*)p.o[0], p.i[1]);
    if (PH == 1) gla_state<float>((const float*)p.a[0], p.i[0], (const float*)p.a[1], p.i[0], (const float*)p.a[2], (float*)p.o[0], p.i[1]);
    if (PH == 2) gla_scores<float>((const float*)p.a[0], p.i[0], (const float*)p.a[1], p.i[0], (const float*)p.a[2], (float*)p.o[0], p.i[1]);
    if (PH == 3) gla_out<float>((const float*)p.a[0], p.i[0], (const float*)p.a[1], p.i[0], (const float*)p.a[2], (const float*)p.a[3], (const float*)p.a[4], (float*)p.o[0], p.i[1]);
    if (PH == 4) gla_norm<float, float>((const float*)p.a[0], (const float*)p.a[1], p.i[0], (const float*)p.a[2], (float*)p.o[0], p.i[1]);
    if (PH == 5) res_ln<float>((const float*)p.a[0], (const float*)p.a[1], (const float*)p.a[2], (const float*)p.a[3], (float*)p.o[0], (float*)nullptr, p.i[1]);
    if (PH == 6) ple_elt((const float*)p.a[0], (const float*)p.a[1], (const float*)p.a[2], (float*)p.o[0], (size_t)p.i[1] * D);
    if (PH == 7) mla_prep<float, float>((const float*)p.a[0], p.i[0], (const float*)p.a[1], (const float*)p.a[2], (const int*)p.a[3], (float*)p.o[0], (float*)p.o[1], (float*)p.o[2], p.i[1]);
    if (PH == 8) mla_qrope<float>((float*)p.o[0], (const int*)p.a[0], p.i[1]);
    if (PH == 9) mla_attn<float, float>((const float*)p.a[0], (const float*)p.a[1], (const float*)p.a[2], (float*)p.o[0], p.i[1], sc + (threadIdx.x >> 6) * S);
    if (PH == 10) conv_mix<float, float>((const float*)p.a[0], p.i[0], (const float*)p.a[1], (float*)p.o[0], p.i[1]);
}
}

template <int EPI> static void gemm(hipStream_t st, const float* A, int lda, const float* W, int ldw, float* C, int ldc, int Mr, int N, int K) {
    hipLaunchKernelGGL((k_gemm<EPI>), dim3((N + 127) / 128, Mr / 128), dim3(256), 0, st, A, lda, W, ldw, C, ldc, Mr, N, K);
}
template <int PH> static void phase(hipStream_t st, const P& p, int grid = 2048) { hipLaunchKernelGGL((k_phase<PH>), dim3(grid), dim3(256), 0, st, p); }

extern "C" void kernel_launch(void* const* d_in, const int* in_sizes, int n_in, void* d_out, int out_size, void* d_ws, size_t ws_size, hipStream_t stream) {
    const float* x_in = (const float*)d_in[0]; const float* p_in = (const float*)d_in[1]; const int* pos = (const int*)d_in[2];
    const float *gla_w_in = (const float*)d_in[3], *gla_wgu = (const float*)d_in[4], *gla_bg = (const float*)d_in[5], *gla_ng = (const float*)d_in[6], *gla_w_out = (const float*)d_in[7];
    const float *mla_w_in = (const float*)d_in[8], *mla_qn = (const float*)d_in[9], *mla_kvn = (const float*)d_in[10], *mla_wuq = (const float*)d_in[11], *mla_wukv = (const float*)d_in[12], *mla_w_out = (const float*)d_in[13];
    const float *conv_w_in = (const float*)d_in[14], *conv_w = (const float*)d_in[15], *conv_w_out = (const float*)d_in[16];
    const float *ln_g = (const float*)d_in[17], *ln_b = (const float*)d_in[18], *w1 = (const float*)d_in[19], *w2 = (const float*)d_in[20], *wg = (const float*)d_in[21], *wp = (const float*)d_in[22];
    float* out = (float*)d_out;
    constexpr int NBL = 2, ML = NBL * S;
    const size_t MiB = 1u << 20;
    float* ws = (float*)d_ws;
    float* XA = ws;
    float* XB = XA + (size_t)ML * D;
    float* HB = XB + (size_t)ML * D;
    float* BIG = HB + (size_t)ML * D;
    float* LB = BIG + (size_t)ML * FF;
    float* ST = LB + (size_t)ML * GHK;
    float* SC = ST + (size_t)NBL * GH * NCH * GDK * GDV;
    float* O1 = SC + (size_t)NBL * GH * NCH * CH * CH;
    float* O2 = O1 + (size_t)ML * D;
    (void)MiB; (void)in_sizes; (void)n_in; (void)out_size; (void)ws_size;
    for (int pass = 0; pass < NB / NBL; ++pass) {
        const size_t r0 = (size_t)pass * ML;
        const float* x = x_in + r0 * D;
        for (int i = 0; i < DEPTH; ++i) {
            const int j = i / 3, kind = i % 3;
            float* h = HB;
            if (kind == 0) {
                gemm<0>(stream, x, D, gla_w_in + (size_t)j * D * GLA_IN, GLA_IN, BIG, GLA_IN, ML, GLA_IN, D);
                { P p{}; p.a[0] = BIG + 3072; p.i[0] = GLA_IN; p.a[1] = gla_wgu + (size_t)j * GRANK * GHK; p.a[2] = gla_bg + (size_t)j * GHK; p.o[0] = LB; p.i[1] = ML; phase<0>(stream, p); }
                { P p{}; p.a[0] = BIG + 512; p.a[1] = BIG + 1024; p.i[0] = GLA_IN; p.a[2] = LB; p.o[0] = ST; p.i[1] = NBL; phase<1>(stream, p); }
                { P p{}; p.a[0] = BIG; p.a[1] = BIG + 512; p.i[0] = GLA_IN; p.a[2] = LB; p.o[0] = SC; p.i[1] = NBL; phase<2>(stream, p); }
                { P p{}; p.a[0] = BIG; p.a[1] = BIG + 1024; p.i[0] = GLA_IN; p.a[2] = LB; p.a[3] = SC; p.a[4] = ST; p.o[0] = O1; p.i[1] = NBL; phase<3>(stream, p); }
                { P p{}; p.a[0] = O1; p.a[1] = BIG + 2048; p.i[0] = GLA_IN; p.a[2] = gla_ng + (size_t)j * GDV; p.o[0] = O2; p.i[1] = ML; phase<4>(stream, p); }
                gemm<0>(stream, O2, D, gla_w_out + (size_t)j * GHV * D, D, h, D, ML, D, GHV);
            } else if (kind == 1) {
                gemm<0>(stream, x, D, mla_w_in + (size_t)j * D * MLA_IN, MLA_IN, BIG, MLA_IN, ML, MLA_IN, D);
                float* cqn = LB; float* ckvn = LB + (size_t)ML * 256; float* kr = SC; float* q = ST; float* kv = O1;
                { P p{}; p.a[0] = BIG; p.i[0] = MLA_IN; p.a[1] = mla_qn + j * 256; p.a[2] = mla_kvn + j * 256; p.a[3] = pos + r0; p.o[0] = cqn; p.o[1] = ckvn; p.o[2] = kr; p.i[1] = ML; phase<7>(stream, p); }
                gemm<0>(stream, cqn, 256, mla_wuq + (size_t)j * 256 * 1536, 1536, q, 1536, ML, 1536, 256);
                gemm<0>(stream, ckvn, 256, mla_wukv + (size_t)j * 256 * 2048, 2048, kv, 2048, ML, 2048, 256);
                { P p{}; p.a[0] = pos + r0; p.o[0] = q; p.i[1] = ML; phase<8>(stream, p); }
                { P p{}; p.a[0] = q; p.a[1] = kv; p.a[2] = kr; p.o[0] = XB; p.i[1] = NBL; phase<9>(stream, p); }
                gemm<0>(stream, XB, D, mla_w_out + (size_t)j * D * D, D, h, D, ML, D, D);
            } else {
                gemm<0>(stream, x, D, conv_w_in + (size_t)j * D * 3 * D, 3 * D, BIG, 3 * D, ML, 3 * D, D);
                { P p{}; p.a[0] = BIG; p.i[0] = 3 * D; p.a[1] = conv_w + (size_t)j * 3 * D; p.o[0] = O1; p.i[1] = ML; phase<10>(stream, p); }
                gemm<0>(stream, O1, D, conv_w_out + (size_t)j * D * D, D, h, D, ML, D, D);
            }
            { P p{}; p.a[0] = x; p.a[1] = h; p.a[2] = ln_g + (size_t)(i * 2) * D; p.a[3] = ln_b + (size_t)(i * 2) * D; p.o[0] = XB; p.i[1] = ML; phase<5>(stream, p); }
            gemm<1>(stream, XB, D, w1 + (size_t)i * D * FF, FF, BIG, FF, ML, FF, D);
            gemm<0>(stream, BIG, FF, w2 + (size_t)i * FF * D, D, h, D, ML, D, FF);
            { P p{}; p.a[0] = XB; p.a[1] = h; p.a[2] = ln_g + (size_t)(i * 2 + 1) * D; p.a[3] = ln_b + (size_t)(i * 2 + 1) * D; p.o[0] = O1; p.i[1] = ML; phase<5>(stream, p); }
            gemm<0>(stream, O1, D, wg + (size_t)i * D * D, D, h, D, ML, D, D);
            gemm<0>(stream, p_in + ((size_t)i * M + r0) * PLE, PLE, wp + (size_t)i * PLE * D, D, O2, D, ML, D, PLE);
            float* x3 = (i == DEPTH - 1) ? out + r0 * D : XA;
            { P p{}; p.a[0] = O1; p.a[1] = h; p.a[2] = O2; p.o[0] = x3; p.i[1] = ML; phase<6>(stream, p); }
            x = XA;
        }
    }
}
```

```cpp
#include <hip/hip_runtime.h>
#include <hip/hip_cooperative_groups.h>
#include <cstdint>
#include <cstdio>
namespace cg = cooperative_groups;

constexpr int NB = 8, S = 2048, D = 1024, M = NB * S, DEPTH = 4, CH = 64, NCH = S / CH;
constexpr int FF = 4096, PLE = 256;
constexpr int GLA_IN = 3088, GH = 4, GDK = 128, GDV = 256, GHK = 512, GHV = 1024, GRANK = 16;
constexpr int MLA_IN = 576, MLA_INP = 768, MH = 8, MNOPE = 128, MROPE = 64, MV = 128, MQK = 192;
constexpr float ALPHA = 1.6817928305074290860622509524664f;
constexpr float LN_EPS = 1e-5f, RMS_EPS = 1e-6f;

typedef unsigned short bf16_t;
__device__ __forceinline__ float ldf(const float* p, size_t i) { return p[i]; }
__device__ __forceinline__ float ldf(const bf16_t* p, size_t i) { return __uint_as_float(((unsigned)p[i]) << 16); }
__device__ __forceinline__ unsigned f2bf(float f) { unsigned u = __float_as_uint(f); return (u + 0x7fffu + ((u >> 16) & 1u)) >> 16; }
__device__ __forceinline__ unsigned pk2(float lo, float hi) { return f2bf(lo) | (f2bf(hi) << 16); }
__device__ __forceinline__ float bflo(unsigned w) { return __uint_as_float(w << 16); }
__device__ __forceinline__ float bfhi(unsigned w) { return __uint_as_float(w & 0xffff0000u); }
__device__ __forceinline__ void stf(float* p, size_t i, float v) { p[i] = v; }
__device__ __forceinline__ void stf(bf16_t* p, size_t i, float v) { p[i] = (bf16_t)f2bf(v); }
__device__ __forceinline__ float wave_sum(float v) {
#pragma unroll
    for (int o = 1; o < 64; o <<= 1) v += __shfl_xor(v, o);
    return v;
}
__device__ __forceinline__ float wave_max(float v) {
#pragma unroll
    for (int o = 1; o < 64; o <<= 1) v = fmaxf(v, __shfl_xor(v, o));
    return v;
}
__device__ __forceinline__ float log_sigmoid(float z) { return fminf(z, 0.f) - log1pf(expf(-fabsf(z))); }
__device__ __forceinline__ float sigmoidf_(float z) { return 1.f / (1.f + expf(-z)); }
__device__ const float INV_FREQ[32] = {1.0f, 0.7498942017555237f, 0.5623413324356079f, 0.4216965138912201f, 0.3162277638912201f, 0.23713737726211548f, 0.17782793939113617f, 0.1333521455526352f, 0.10000000149011612f, 0.0749894231557846f, 0.05623413249850273f, 0.04216964915394783f, 0.03162277489900589f, 0.023713737726211548f, 0.017782794311642647f, 0.013335213996469975f, 0.009999999776482582f, 0.007498942315578461f, 0.005623413249850273f, 0.0042169648222625256f, 0.003162277629598975f, 0.0023713738191872835f, 0.0017782794311642647f, 0.0013335214462131262f, 0.0010000000474974513f, 0.0007498941849917173f, 0.000562341301701963f, 0.0004216965171508491f, 0.0003162277571391314f, 0.00023713737027719617f, 0.00017782794020604342f, 0.0001333521504420787f};
__device__ __forceinline__ float inv_freq(int j) { return INV_FREQ[j]; }

constexpr int NTHR = 512;
__device__ __forceinline__ int tid_now() { int t = threadIdx.x; asm volatile("" : "+v"(t)); return t; }
__device__ __forceinline__ int bid_now() { int b = blockIdx.x; asm volatile("" : "+s"(b)); return b; }
#define GSTRIDE(i, n) for (size_t i = (size_t)bid_now() * NTHR + tid_now(), _st = (size_t)gridDim.x * NTHR; i < (size_t)(n); i += _st)
#define WSTRIDE_DECL const int _t = tid_now(); const int lane = _t & 63; const size_t gw = ((size_t)bid_now() * NTHR + _t) >> 6, nw = ((size_t)gridDim.x * NTHR) >> 6

template <class T> __device__ __forceinline__ void gla_glr(const T* xb, const float* Win, float* glr, int Mloc) {
    WSTRIDE_DECL;
    for (size_t m = gw; m < (size_t)Mloc; m += nw) {
        float acc[GRANK];
#pragma unroll
        for (int r = 0; r < GRANK; ++r) acc[r] = 0.f;
        for (int i = 0; i < D / 64; ++i) { const int k = lane + 64 * i; const float xv = ldf(xb, m * D + k); const float* w = Win + (size_t)k * GLA_IN + 3072;
#pragma unroll
            for (int r = 0; r < GRANK; ++r) acc[r] += xv * w[r]; }
#pragma unroll
        for (int r = 0; r < GRANK; ++r) { const float s = wave_sum(acc[r]); if (lane == r) glr[m * GRANK + r] = s; }
    }
}
template <class T> __device__ __forceinline__ void gla_L(const T* glr, int ldg, const float* wgu, const float* bg, float* L, int Mloc) {
    GSTRIDE(idx, (size_t)(Mloc / CH) * GHK) {
        const int ch = (int)(idx % GHK); const int cn = (int)(idx / GHK);
        float acc = 0.f;
        for (int t = 0; t < CH; ++t) {
            const size_t m = (size_t)cn * CH + t; float z = bg[ch];
            for (int r = 0; r < GRANK; ++r) z += ldf(glr, m * ldg + r) * wgu[r * GHK + ch];
            acc += log_sigmoid(z) * (1.f / 16.f);
            L[m * GHK + ch] = acc;
        }
    }
}
template <class T, class TO> __device__ __forceinline__ void gla_state(const T* k, int ldk, const T* v, int ldv, const float* L, TO* ST, int nb) {
    GSTRIDE(idx, (size_t)nb * GH * GDK * GDV) {
        const int dv = (int)(idx % GDV), dk = (int)((idx / GDV) % GDK), h = (int)((idx / (GDV * GDK)) % GH), b = (int)(idx / ((size_t)GDV * GDK * GH));
        float st = 0.f;
        for (int n = 0; n < NCH; ++n) {
            stf(ST, (((size_t)(b * GH + h) * NCH + n) * GDK + dk) * GDV + dv, st);
            const size_t m0 = (size_t)b * S + n * CH;
            const float Lend = L[(m0 + CH - 1) * GHK + h * GDK + dk];
            float acc = 0.f;
            for (int s = 0; s < CH; ++s) { const size_t m = m0 + s; acc += ldf(k, m * ldk + h * GDK + dk) * expf(Lend - L[m * GHK + h * GDK + dk]) * ldf(v, m * ldv + h * GDV + dv); }
            st = expf(Lend) * st + acc;
        }
    }
}
template <class T> __device__ __forceinline__ void gla_scores(const T* q, int ldq, const T* k, int ldk, const float* L, float* SC, int nb) {
    GSTRIDE(idx, (size_t)nb * GH * NCH * CH * CH) {
        const int s = (int)(idx % CH), t = (int)((idx / CH) % CH); const size_t unit = idx / (CH * CH);
        const int n = (int)(unit % NCH), h = (int)((unit / NCH) % GH), b = (int)(unit / (NCH * GH));
        const size_t mt = (size_t)b * S + n * CH + t, ms = (size_t)b * S + n * CH + s;
        float acc = 0.f;
        for (int d = 0; d < GDK; ++d) acc += ldf(q, mt * ldq + h * GDK + d) * ldf(k, ms * ldk + h * GDK + d) * expf(-fabsf(L[mt * GHK + h * GDK + d] - L[ms * GHK + h * GDK + d]));
        SC[idx] = acc * 0.088388347648318440550f;
    }
}
template <class T, class TS, class TO> __device__ __forceinline__ void gla_out_norm(const T* q, int ldq, const T* v, int ldv, const T* r, int ldr, const float* L, const float* SC, const TS* ST, const float* g, TO* OG, int Mloc) {
    WSTRIDE_DECL;
    for (size_t it = gw; it < (size_t)Mloc * GH; it += nw) {
        const size_t m = it / GH; const int h = (int)(it % GH);
        const int b = (int)(m / S), tt = (int)(m % S), n = tt / CH, t = tt % CH;
        const size_t unit = (size_t)(b * GH + h) * NCH + n, m0 = (size_t)b * S + n * CH;
        float o[4] = {0.f, 0.f, 0.f, 0.f};
        for (int s = 0; s < CH; ++s) { const float sc = SC[(unit * CH + t) * CH + s];
#pragma unroll
            for (int j = 0; j < 4; ++j) o[j] += sc * ldf(v, (m0 + s) * ldv + h * GDV + lane + 64 * j); }
        float o2[4] = {0.f, 0.f, 0.f, 0.f};
        for (int dk = 0; dk < GDK; ++dk) { const float qe = ldf(q, m * ldq + h * GDK + dk) * expf(L[m * GHK + h * GDK + dk]);
#pragma unroll
            for (int j = 0; j < 4; ++j) o2[j] += qe * ldf(ST, (unit * GDK + dk) * GDV + lane + 64 * j); }
        float ss = 0.f;
#pragma unroll
        for (int j = 0; j < 4; ++j) { o[j] += o2[j] * 0.088388347648318440550f; ss += o[j] * o[j]; }
        const float rstd = rsqrtf(wave_sum(ss) * (1.f / GDV) + RMS_EPS);
#pragma unroll
        for (int j = 0; j < 4; ++j) { const int dv = lane + 64 * j; const float rv = ldf(r, m * ldr + h * GDV + dv); stf(OG, m * GHV + h * GDV + dv, o[j] * rstd * g[dv] * (rv * sigmoidf_(rv))); }
    }
}
template <class T, class TO> __device__ __forceinline__ void mla_prep(const T* Cb, int ldc, const float* qn, const float* kvn, const float* cs, TO* cqn, TO* ckvn, TO* kr, int Mloc) {
    WSTRIDE_DECL;
    for (size_t m = gw; m < (size_t)Mloc; m += nw) {
        float a[4], c[4], sa = 0.f, sc = 0.f;
#pragma unroll
        for (int j = 0; j < 4; ++j) { a[j] = ldf(Cb, m * ldc + lane + 64 * j); c[j] = ldf(Cb, m * ldc + 256 + lane + 64 * j); sa += a[j] * a[j]; sc += c[j] * c[j]; }
        const float ra = rsqrtf(wave_sum(sa) * (1.f / 256.f) + RMS_EPS), rc = rsqrtf(wave_sum(sc) * (1.f / 256.f) + RMS_EPS);
#pragma unroll
        for (int j = 0; j < 4; ++j) { const int d = lane + 64 * j; stf(cqn, m * 256 + d, a[j] * ra * qn[d]); stf(ckvn, m * 256 + d, c[j] * rc * kvn[d]); }
        if (lane < 32) {
            const float x1 = ldf(Cb, m * ldc + 512 + lane), x2 = ldf(Cb, m * ldc + 544 + lane);
            const float csn = cs[m * 64 + lane], sn = cs[m * 64 + 32 + lane];
            stf(kr, m * 64 + lane, x1 * csn - x2 * sn); stf(kr, m * 64 + 32 + lane, x2 * csn + x1 * sn);
        }
    }
}
template <class T> __device__ __forceinline__ void mla_qrope(T* q, const float* cs, int Mloc) {
    GSTRIDE(idx, (size_t)Mloc * MH * 32) {
        const int j = (int)(idx % 32), h = (int)((idx / 32) % MH); const size_t m = idx / (32 * MH);
        const size_t o = m * (MH * MQK) + h * MQK + MNOPE + j;
        const float x1 = ldf(q, o), x2 = ldf(q, o + 32);
        const float csn = cs[m * 64 + j], sn = cs[m * 64 + 32 + j];
        stf(q, o, x1 * csn - x2 * sn); stf(q, o + 32, x2 * csn + x1 * sn);
    }
}
template <class T, class TO> __device__ __forceinline__ void mla_attn(const T* q, const T* kv, const T* kr, TO* o, int nb, float* sc) {
    WSTRIDE_DECL;
    for (size_t it = gw; it < (size_t)nb * MH * S; it += nw) {
        const int qi = (int)(it % S), h = (int)((it / S) % MH), b = (int)(it / ((size_t)S * MH));
        const size_t m = (size_t)b * S + qi; const int lim = (qi / CH + 1) * CH;
        const T* qp = q + m * (MH * MQK) + h * MQK;
        float mx = -INFINITY;
        for (int s = lane; s < lim; s += 64) {
            const size_t ms = (size_t)b * S + s; const T* kp = kv + ms * (MH * 256) + h * 256; const T* rp = kr + ms * 64;
            float dot = 0.f;
            for (int d = 0; d < MNOPE; ++d) dot += ldf(qp, d) * ldf(kp, d);
            for (int j = 0; j < MROPE; ++j) dot += ldf(qp, MNOPE + j) * ldf(rp, j);
            dot *= 0.072168783648703220564f;
            sc[s] = dot; mx = fmaxf(mx, dot);
        }
        mx = wave_max(mx);
        float sum = 0.f;
        for (int s = lane; s < lim; s += 64) { const float p = expf(sc[s] - mx); sc[s] = p; sum += p; }
        sum = wave_sum(sum);
        __builtin_amdgcn_s_waitcnt(0); __builtin_amdgcn_wave_barrier();
        float a0 = 0.f, a1 = 0.f;
        for (int s = 0; s < lim; ++s) { const size_t ms = (size_t)b * S + s; const float p = sc[s]; a0 += p * ldf(kv, ms * (MH * 256) + h * 256 + 128 + lane); a1 += p * ldf(kv, ms * (MH * 256) + h * 256 + 192 + lane); }
        const float inv = 1.f / sum;
        stf(o, m * (MH * MV) + h * MV + lane, a0 * inv); stf(o, m * (MH * MV) + h * MV + 64 + lane, a1 * inv);
        __builtin_amdgcn_s_waitcnt(0); __builtin_amdgcn_wave_barrier();
    }
}
template <class T, class TO> __device__ __forceinline__ void conv_mix(const T* bcu, int ld, const float* cw, TO* a, int Mloc) {
    GSTRIDE(idx, (size_t)Mloc * D) {
        const int c = (int)(idx % D); const size_t m = idx / D; const int t = (int)(m % S);
        float z = 0.f;
#pragma unroll
        for (int j = 0; j < 3; ++j) { const int dt = 2 - j; if (t - dt >= 0) { const size_t mm = m - dt; z += cw[j * D + c] * ldf(bcu, mm * ld + D + c) * ldf(bcu, mm * ld + 2 * D + c); } }
        stf(a, idx, ldf(bcu, m * ld + c) * z);
    }
}
namespace pg8 {
#define PG8_LAS __attribute__((address_space(3)))
typedef unsigned short bf16_t;
typedef short bf16x8 __attribute__((ext_vector_type(8)));
typedef float f32x4 __attribute__((ext_vector_type(4)));
typedef unsigned u32x4 __attribute__((ext_vector_type(4)));
constexpr int BM = 256, BK = 64, HALF = 128, HTB = HALF * BK * 2  , STAGE_BYTES = 8 * HTB, NXCD = 8, WGM = 8;

__host__ __device__ __forceinline__ int lds_byte(int r, int c) { const int st = (r >> 4) * 2 + (c >> 5), rr = r & 15, cc = c & 31, ob = rr * 64 + cc * 2; return st * 1024 + (ob ^ (((ob >> 9) & 1) << 5)); }
__host__ __device__ __forceinline__ void stage_rc(int b, int& R, int& C) { const int st = b / 1024, sb = b % 1024, swz = sb ^ (((sb >> 9) & 1) << 5); R = (st >> 1) * 16 + swz / 64; C = (st & 1) * 32 + (swz % 64) / 2; }
__host__ __device__ __forceinline__ int perm32(int rho) { const int n = rho >> 4, i = rho & 15; return 8 * (i >> 2) + 4 * n + (i & 3); }

struct Unit { int pm, pn; };
struct Gemm { const bf16_t* A; const bf16_t* Bt; int M, N, K; };

struct StaticOrder {
    int nM, nN, nwg, G, c;
    __host__ __device__ void init(int M, int N, int G_, int c_) { nM = M / BM; nN = N / BM; nwg = nM * nN; G = G_; c = c_; }
    __host__ __device__ bool next(int i, Unit& u) const {
        const long L = (long)i * G + c; if (L >= nwg) return false;
        int wgid = (int)L; { const int q = nwg / NXCD, r = nwg % NXCD, xcd = wgid % NXCD, off = wgid / NXCD; wgid = (xcd < r ? xcd * (q + 1) : r * (q + 1) + (xcd - r) * q) + off; }
        const int nig = WGM * nN, gid = wgid / nig, fm = gid * WGM, gsz = (nM - fm) < WGM ? (nM - fm) : WGM;
        u.pm = fm + ((wgid % nig) % gsz); u.pn = (wgid % nig) / gsz; return true;
    }
    __device__ __forceinline__ void a_ready(const Unit&) const {}
    __device__ __forceinline__ void done(const Unit&) const {}
};


__device__ __forceinline__ unsigned cvt_pk_bf16(float lo, float hi) { unsigned r; asm volatile("v_cvt_pk_bf16_f32 %0, %1, %2" : "=v"(r) : "v"(lo), "v"(hi)); return r; }
typedef unsigned u32x2 __attribute__((ext_vector_type(2)));
template <int ACT  > struct EpiBf16 {
    static constexpr bool PERM = true, AFTER_DRAIN = false;
    bf16_t* O; int ldc;
    __device__ __forceinline__ void operator()(const f32x4 (&acc)[2][2][4][2], const Unit& u, int wr, int wc, int fr, int fq) const {
        const int row0 = u.pm * BM + wr * 64 + fr, col0 = u.pn * BM + wc * 32 + 8 * fq;
#pragma unroll
        for (int ai = 0; ai < 2; ++ai)
#pragma unroll
            for (int m = 0; m < 4; ++m) { bf16_t* rowp = O + (size_t)(row0 + ai * HALF + m * 16) * ldc + col0;
#pragma unroll
                for (int bj = 0; bj < 2; ++bj) { f32x4 v0 = acc[ai][bj][m][0], v1 = acc[ai][bj][m][1];
                    if (ACT == 2) {
#pragma unroll
                        for (int e = 0; e < 4; ++e) { float a = fmaxf(v0[e], 0.f); v0[e] = a * a; float b = fmaxf(v1[e], 0.f); v1[e] = b * b; } }
                    u32x4 w; w.x = cvt_pk_bf16(v0[0], v0[1]); w.y = cvt_pk_bf16(v0[2], v0[3]); w.z = cvt_pk_bf16(v1[0], v1[1]); w.w = cvt_pk_bf16(v1[2], v1[3]);
                    *(u32x4*)(rowp + bj * HALF) = w; } }
    }
};
struct EpiRes {
    static constexpr bool PERM = false, AFTER_DRAIN = false;
    const float* base; float* out; int ldc; float alpha;
    __device__ __forceinline__ void operator()(const f32x4 (&acc)[2][2][4][2], const Unit& u, int wr, int wc, int fr, int fq) const {
        const int col0 = u.pn * BM + wc * 32 + 4 * fq;
#pragma unroll
        for (int ai = 0; ai < 2; ++ai)
#pragma unroll
            for (int m = 0; m < 4; ++m) { const size_t off = (size_t)(u.pm * BM + ai * HALF + wr * 64 + m * 16 + fr) * ldc + col0;
#pragma unroll
                for (int bj = 0; bj < 2; ++bj)
#pragma unroll
                    for (int n = 0; n < 2; ++n) { const f32x4 bs = *(const f32x4*)(base + off + bj * HALF + n * 16); *(f32x4*)(out + off + bj * HALF + n * 16) = bs * alpha + acc[ai][bj][m][n]; } }
    }
};
struct EpiPle {
    static constexpr bool PERM = false, AFTER_DRAIN = false;
    const float* xin; float* xout; const bf16_t* P; bf16_t* xb; int ldc;
    __device__ __forceinline__ void operator()(const f32x4 (&acc)[2][2][4][2], const Unit& u, int wr, int wc, int fr, int fq) const {
        const int col0 = u.pn * BM + wc * 32 + 4 * fq;
#pragma unroll
        for (int ai = 0; ai < 2; ++ai)
#pragma unroll
            for (int m = 0; m < 4; ++m) { const size_t off = (size_t)(u.pm * BM + ai * HALF + wr * 64 + m * 16 + fr) * ldc + col0;
#pragma unroll
                for (int bj = 0; bj < 2; ++bj)
#pragma unroll
                    for (int n = 0; n < 2; ++n) { const size_t o = off + bj * HALF + n * 16; const f32x4 x2 = *(const f32x4*)(xin + o); const u32x2 pw = *(const u32x2*)(P + o); const f32x4 a = acc[ai][bj][m][n];
                        f32x4 r; r[0] = x2[0] + __uint_as_float(pw.x << 16) / (1.f + __expf(-a[0])); r[1] = x2[1] + __uint_as_float(pw.x & 0xffff0000u) / (1.f + __expf(-a[1]));
                        r[2] = x2[2] + __uint_as_float(pw.y << 16) / (1.f + __expf(-a[2])); r[3] = x2[3] + __uint_as_float(pw.y & 0xffff0000u) / (1.f + __expf(-a[3]));
                        *(f32x4*)(xout + o) = r; u32x2 w; w.x = cvt_pk_bf16(r[0], r[1]); w.y = cvt_pk_bf16(r[2], r[3]); *(u32x2*)(xb + o) = w; } }
    }
};
template <class Epi, class Sched, bool ALIGN_EPI = false, bool SP2 = false>
__device__ __forceinline__ void gemm_phase(PG8_LAS unsigned char* lds, const Gemm g, const Sched& S, const Epi& E) {
    const int tid = tid_now(), wid = __builtin_amdgcn_readfirstlane(tid >> 6), lane = tid & 63, wr = wid >> 2, wc = wid & 3, fr = lane & 15, fq = lane >> 4;
    const int K = g.K, nt = K / BK;
    unsigned voffA[2], voffB[2];
#pragma unroll
    for (int i = 0; i < 2; ++i) { int R, C; stage_rc(tid * 16 + i * 8192, R, C); const int Rb = Epi::PERM ? ((R & ~31) + perm32(R & 31)) : R;
        voffA[i] = (unsigned)(R * K + C) * 2u; voffB[i] = (unsigned)(Rb * K + C) * 2u; }
    const size_t kstep = (size_t)(BK * 2);
    const size_t hstep = (size_t)HALF * K * 2;
    const size_t tstep = 2 * hstep;
    const unsigned ldsw = (unsigned)wid * 1024u;
    const int aoff = lds_byte(wr * 64 + fr, fq * 8), boff = lds_byte(wc * 32 + fr, fq * 8);
#define PG8_SA(b, h) (((b) * 2 + (h)) * HTB)
#define PG8_SB(b, h) ((4 + (b) * 2 + (h)) * HTB)
#define PG8_STAGE(bufoff, gbase, voff) do { _Pragma("unroll") for (int _i = 0; _i < 2; ++_i) \
        __builtin_amdgcn_global_load_lds((const unsigned*)((const char*)(gbase) + (voff)[_i]), (PG8_LAS unsigned*)(lds + (bufoff) + ldsw + _i * 8192), 16, 0, 0); } while (0)
#define PG8_LDA(dst, b, h) do { _Pragma("unroll") for (int m = 0; m < 4; ++m) _Pragma("unroll") for (int k = 0; k < 2; ++k) dst[m][k] = *(const PG8_LAS bf16x8*)(lds + PG8_SA(b, h) + aoff + m * 2048 + k * 1024); } while (0)
#define PG8_LDB(dst, b, h) do { _Pragma("unroll") for (int n = 0; n < 2; ++n) _Pragma("unroll") for (int k = 0; k < 2; ++k) dst[n][k] = *(const PG8_LAS bf16x8*)(lds + PG8_SB(b, h) + boff + n * 2048 + k * 1024); } while (0)
#define PG8_MMA(ai, bj, At, Bt) do { __builtin_amdgcn_s_setprio(1); _Pragma("unroll") for (int m = 0; m < 4; ++m) _Pragma("unroll") for (int n = 0; n < 2; ++n) _Pragma("unroll") for (int k = 0; k < 2; ++k) \
        acc[ai][bj][m][n] = __builtin_amdgcn_mfma_f32_16x16x32_bf16(Bt[n][k], At[m][k], acc[ai][bj][m][n], 0, 0, 0); __builtin_amdgcn_s_setprio(0); } while (0)
#define PG8_WAIT_V(n) asm volatile("s_waitcnt vmcnt(" #n ")" ::: "memory")
#define PG8_WAIT_L(n) asm volatile("s_waitcnt lgkmcnt(" #n ")" ::: "memory")
#define PG8_BAR __builtin_amdgcn_s_barrier()
#define PG8_SCHED __builtin_amdgcn_sched_barrier(0)
    Unit cur, nxt; int ui = 0;
    if (!S.next(0, cur)) return;
    f32x4 acc[2][2][4][2];
#pragma unroll
    for (int a = 0; a < 2; ++a)
#pragma unroll
        for (int b = 0; b < 2; ++b)
#pragma unroll
            for (int m = 0; m < 4; ++m)
#pragma unroll
                for (int n = 0; n < 2; ++n) acc[a][b][m][n] = (f32x4){0.f, 0.f, 0.f, 0.f};
    bf16x8 At[4][2], B0[2][2], B1[2][2];
    const char* cA = (const char*)g.A + (size_t)cur.pm * tstep; const char* cB = (const char*)g.Bt + (size_t)cur.pn * tstep;
    S.a_ready(cur);
    if constexpr (SP2) {
        PG8_STAGE(PG8_SB(0, 0), cB, voffB); PG8_STAGE(PG8_SB(0, 1), cB + hstep, voffB); PG8_STAGE(PG8_SA(0, 0), cA, voffA); PG8_STAGE(PG8_SA(0, 1), cA + hstep, voffA);
        if (wr == 1) PG8_BAR;
        PG8_WAIT_V(2); PG8_BAR;
        PG8_STAGE(PG8_SB(1, 0), cB + kstep, voffB); PG8_STAGE(PG8_SA(1, 0), cA + kstep, voffA); PG8_STAGE(PG8_SB(1, 1), cB + hstep + kstep, voffB);
        PG8_WAIT_V(6); PG8_BAR;
    } else {
        PG8_STAGE(PG8_SB(0, 0), cB, voffB); PG8_STAGE(PG8_SA(0, 0), cA, voffA); PG8_STAGE(PG8_SB(0, 1), cB + hstep, voffB); PG8_STAGE(PG8_SA(0, 1), cA + hstep, voffA);
        if (wr == 1) PG8_BAR;
        PG8_WAIT_V(4); PG8_BAR;
        PG8_STAGE(PG8_SB(1, 0), cB + kstep, voffB); PG8_STAGE(PG8_SA(1, 0), cA + kstep, voffA); PG8_STAGE(PG8_SB(1, 1), cB + hstep + kstep, voffB);
        PG8_WAIT_V(6); PG8_BAR;
    }
    for (;;) {
        const bool has_next = S.next(ui + 1, nxt);
        const char* nA = has_next ? (const char*)g.A + (size_t)nxt.pm * tstep : cA; const char* nB = has_next ? (const char*)g.Bt + (size_t)nxt.pn * tstep : cB;
        for (int t = 0; t < nt; t += 2) {
            const bool last = (t == nt - 2);
            const char* a1 = cA + (size_t)(t + 1) * kstep;
            const char* a2 = last ? nA : cA + (size_t)(t + 2) * kstep; const char* b2 = last ? nB : cB + (size_t)(t + 2) * kstep;
            const char* a3 = a2 + kstep; const char* b3 = b2 + kstep;
            if (last && has_next) S.a_ready(nxt);
            if constexpr (SP2) {
            PG8_LDB(B0, 0, 0); PG8_LDB(B1, 0, 1); PG8_SCHED; PG8_LDA(At, 0, 0); PG8_STAGE(PG8_SA(1, 1), a1 + hstep, voffA);
            PG8_WAIT_V(8); PG8_WAIT_L(0); PG8_BAR; PG8_MMA(0, 0, At, B0); PG8_MMA(0, 1, At, B1); PG8_BAR; PG8_SCHED;
            PG8_LDA(At, 0, 1); PG8_STAGE(PG8_SB(0, 0), b2, voffB); PG8_STAGE(PG8_SB(0, 1), b2 + hstep, voffB); PG8_STAGE(PG8_SA(0, 0), a2, voffA);
            PG8_WAIT_V(8); PG8_WAIT_L(0); PG8_BAR; PG8_MMA(1, 0, At, B0); PG8_MMA(1, 1, At, B1); PG8_BAR; PG8_SCHED;
            PG8_LDB(B0, 1, 0); PG8_LDB(B1, 1, 1); PG8_SCHED; PG8_LDA(At, 1, 0); PG8_STAGE(PG8_SA(0, 1), a2 + hstep, voffA);
            PG8_WAIT_V(8); PG8_WAIT_L(0); PG8_BAR; PG8_MMA(0, 0, At, B0); PG8_MMA(0, 1, At, B1); PG8_BAR; PG8_SCHED;
            PG8_LDA(At, 1, 1); PG8_STAGE(PG8_SB(1, 0), b3, voffB); PG8_STAGE(PG8_SB(1, 1), b3 + hstep, voffB); PG8_STAGE(PG8_SA(1, 0), a3, voffA);
            PG8_WAIT_V(8); PG8_WAIT_L(0); PG8_BAR; PG8_MMA(1, 0, At, B0); PG8_MMA(1, 1, At, B1); PG8_BAR; PG8_SCHED;
            } else {
            PG8_LDB(B0, 0, 0); PG8_SCHED; PG8_LDA(At, 0, 0); PG8_STAGE(PG8_SA(1, 1), a1 + hstep, voffA);
            PG8_WAIT_L(8); PG8_BAR; PG8_WAIT_L(0); PG8_MMA(0, 0, At, B0); PG8_BAR; PG8_SCHED;
            PG8_LDB(B1, 0, 1); PG8_STAGE(PG8_SB(0, 0), b2, voffB);
            PG8_BAR; PG8_WAIT_L(0); PG8_MMA(0, 1, At, B1); PG8_BAR;
            PG8_LDA(At, 0, 1); PG8_STAGE(PG8_SA(0, 0), a2, voffA);
            PG8_BAR; PG8_WAIT_L(0); PG8_MMA(1, 0, At, B0); PG8_BAR; PG8_SCHED;
            PG8_STAGE(PG8_SB(0, 1), b2 + hstep, voffB);
            PG8_WAIT_V(6); PG8_BAR; PG8_MMA(1, 1, At, B1); PG8_BAR;
            PG8_LDB(B0, 1, 0); PG8_SCHED; PG8_LDA(At, 1, 0); PG8_STAGE(PG8_SA(0, 1), a2 + hstep, voffA);
            PG8_WAIT_L(8); PG8_BAR; PG8_WAIT_L(0); PG8_MMA(0, 0, At, B0); PG8_BAR; PG8_SCHED;
            PG8_LDB(B1, 1, 1); PG8_STAGE(PG8_SB(1, 0), b3, voffB);
            PG8_BAR; PG8_WAIT_L(0); PG8_MMA(0, 1, At, B1); PG8_BAR;
            PG8_LDA(At, 1, 1); PG8_STAGE(PG8_SA(1, 0), a3, voffA);
            PG8_BAR; PG8_WAIT_L(0); PG8_MMA(1, 0, At, B0); PG8_BAR; PG8_SCHED;
            PG8_STAGE(PG8_SB(1, 1), b3 + hstep, voffB);
            PG8_WAIT_V(6); PG8_BAR; PG8_MMA(1, 1, At, B1); PG8_BAR;
            }
        }
        if constexpr (ALIGN_EPI) { if (wr == 0) PG8_BAR; }
        if constexpr (!Epi::AFTER_DRAIN) { E(acc, cur, wr, wc, fr, fq); S.done(cur); }
        if (!has_next) break;
#pragma unroll
        for (int a = 0; a < 2; ++a)
#pragma unroll
            for (int b = 0; b < 2; ++b)
#pragma unroll
                for (int m = 0; m < 4; ++m)
#pragma unroll
                    for (int n = 0; n < 2; ++n) acc[a][b][m][n] = (f32x4){0.f, 0.f, 0.f, 0.f};
        cur = nxt; cA = nA; cB = nB; ++ui;
        if constexpr (ALIGN_EPI) { if (wr == 1) PG8_BAR; }
    }
    PG8_WAIT_V(0);
    if constexpr (!ALIGN_EPI) { if (wr == 0) PG8_BAR; }
    PG8_BAR;
    if constexpr (Epi::AFTER_DRAIN) { E.fused(acc, cur, wr, wc, fr, fq, lds, wid, lane); S.done(cur); }
#undef PG8_SA
#undef PG8_SB
#undef PG8_STAGE
#undef PG8_LDA
#undef PG8_LDB
#undef PG8_MMA
#undef PG8_WAIT_V
#undef PG8_WAIT_L
#undef PG8_BAR
#undef PG8_SCHED
}
}

#define LAS __attribute__((address_space(3)))
typedef float f32x4 __attribute__((ext_vector_type(4)));
typedef unsigned v4u __attribute__((ext_vector_type(4)));
typedef unsigned v2u __attribute__((ext_vector_type(2)));
constexpr int NWAVES = 8, NTHREADS = 512;
constexpr int LDS_BYTES = 147456;
constexpr size_t MiB = 1u << 20;
constexpr size_t WS_CTL = 0, WS_CS = 1 * MiB, WS_WSET0 = 5 * MiB, WS_WSET1 = 32 * MiB, WS_B0 = 59 * MiB, WS_B1 = 91 * MiB, WS_BIG = 123 * MiB, WS_AUX = 251 * MiB, WS_PP = 299 * MiB, WS_GLR = 331 * MiB, WS_END = 332 * MiB;
constexpr size_t WO_IN = 0, WO_UQ = 786432, WO_UKV = 1179648, WO_OUT = 3145728, WO_W1 = 4194304, WO_W2 = 8388608, WO_G = 12582912, WO_P = 13631488, WO_END = 13893632;
static_assert(WO_END * 2 <= 27 * MiB, "weight set fits its 27 MiB");

struct Args { const void* in[23]; float* out; unsigned char* ws; };

struct Ctx { int tid, lane, wave, gw, ngw, bid; LAS unsigned char* lds; };

__device__ __forceinline__ void tr_matrix(const Ctx& c, const float* W, int ldw, int K, int N, bf16_t* WT) {
    LAS float* scr = (LAS float*)(c.lds + c.wave * 16384);
    const int nblk = N / 32, nitems = (K / 64) * nblk, lane = c.lane;
    for (int it = c.gw; it < nitems; it += c.ngw) {
        const int kb = it / nblk, nb = it % nblk, k0 = 64 * kb, n0 = 32 * nb;
#pragma unroll 8
        for (int i = 0; i < 32; ++i) { const int kk = 2 * i + (lane >> 5); scr[kk * 33 + (lane & 31)] = W[(size_t)(k0 + kk) * ldw + n0 + (lane & 31)]; }
        asm volatile("s_waitcnt lgkmcnt(0)" ::: "memory");
        const int ch = lane & 7;
#pragma unroll
        for (int j = 0; j < 4; ++j) { const int n = (lane >> 3) + 8 * j; const LAS float* s = scr + (8 * ch) * 33 + n;
            v4u o; o.x = pk2(s[0 * 33], s[1 * 33]); o.y = pk2(s[2 * 33], s[3 * 33]); o.z = pk2(s[4 * 33], s[5 * 33]); o.w = pk2(s[6 * 33], s[7 * 33]);
            *(v4u*)(WT + (size_t)(n0 + n) * K + k0 + 8 * ch) = o; }
        asm volatile("s_waitcnt lgkmcnt(0)" ::: "memory");
    }
}
__device__ __forceinline__ void convert_weights(const Ctx& c, const Args& a, int i, bf16_t* WS) {
    const int j = i / 3, kind = i % 3;
    if (kind == 0) {
        tr_matrix(c, (const float*)a.in[3] + (size_t)j * D * GLA_IN, GLA_IN, D, 3072, WS + WO_IN);
        tr_matrix(c, (const float*)a.in[7] + (size_t)j * GHV * D, D, GHV, D, WS + WO_OUT);
    } else if (kind == 1) {
        tr_matrix(c, (const float*)a.in[8] + (size_t)j * D * MLA_IN, MLA_IN, D, MLA_IN, WS + WO_IN);
        for (size_t e = (size_t)c.bid * NTHREADS + c.tid; e < (size_t)(MLA_INP - MLA_IN) * D / 8; e += (size_t)gridDim.x * NTHREADS) *((v4u*)(WS + WO_IN + (size_t)MLA_IN * D) + e) = (v4u){0u, 0u, 0u, 0u};
        tr_matrix(c, (const float*)a.in[11] + (size_t)j * 256 * 1536, 1536, 256, 1536, WS + WO_UQ);
        tr_matrix(c, (const float*)a.in[12] + (size_t)j * 256 * 2048, 2048, 256, 2048, WS + WO_UKV);
        tr_matrix(c, (const float*)a.in[13] + (size_t)j * D * D, D, D, D, WS + WO_OUT);
    } else {
        tr_matrix(c, (const float*)a.in[14] + (size_t)j * D * 3 * D, 3 * D, D, 3 * D, WS + WO_IN);
        tr_matrix(c, (const float*)a.in[16] + (size_t)j * D * D, D, D, D, WS + WO_OUT);
    }
    tr_matrix(c, (const float*)a.in[19] + (size_t)i * D * FF, FF, D, FF, WS + WO_W1);
    tr_matrix(c, (const float*)a.in[20] + (size_t)i * FF * D, D, FF, D, WS + WO_W2);
    tr_matrix(c, (const float*)a.in[21] + (size_t)i * D * D, D, D, D, WS + WO_G);
    tr_matrix(c, (const float*)a.in[22] + (size_t)i * PLE * D, D, PLE, D, WS + WO_P);
}
__device__ __forceinline__ void cvt_rows(const Ctx& c, const float* src, bf16_t* dst, size_t n) {
    for (size_t e = (size_t)c.bid * NTHREADS + c.tid; e < n / 4; e += (size_t)gridDim.x * NTHREADS) { const f32x4 v = ((const f32x4*)src)[e]; v2u o; o.x = pk2(v.x, v.y); o.y = pk2(v.z, v.w); ((v2u*)dst)[e] = o; }
}
__device__ __forceinline__ void ln_pass(const Ctx& c, float* X, const float* g, const float* b, bf16_t* xb) {
    for (int m = c.gw; m < M; m += c.ngw) {
        f32x4* xr = (f32x4*)(X + (size_t)m * D) + c.lane;
        f32x4 v[4]; float s = 0.f;
#pragma unroll
        for (int j = 0; j < 4; ++j) { v[j] = xr[64 * j]; s += (v[j].x + v[j].y) + (v[j].z + v[j].w); }
        const float mean = wave_sum(s) * (1.f / D); float s2 = 0.f;
#pragma unroll
        for (int j = 0; j < 4; ++j) { v[j] = v[j] - mean; s2 += (v[j].x * v[j].x + v[j].y * v[j].y) + (v[j].z * v[j].z + v[j].w * v[j].w); }
        const float rstd = 1.f / sqrtf(wave_sum(s2) * (1.f / D) + LN_EPS);
        v2u* o8 = (v2u*)(xb + (size_t)m * D) + c.lane;
#pragma unroll
        for (int j = 0; j < 4; ++j) { const f32x4 gg = ((const f32x4*)g)[c.lane + 64 * j], bb = ((const f32x4*)b)[c.lane + 64 * j]; const f32x4 o = v[j] * rstd * gg + bb;
            xr[64 * j] = o; v2u w; w.x = pk2(o.x, o.y); w.y = pk2(o.z, o.w); o8[64 * j] = w; }
    }
}


enum { T_NOP = 0, T_PROLOGUE, T_GEMM_BF16, T_GEMM_RELU2, T_GEMM_RES, T_GEMM_PLE, T_GLR, T_GLA_L, T_GLA_STATE, T_GLA_SCORES, T_GLA_OUTNORM, T_MLA_PREP, T_MLA_QROPE, T_MLA_ATTN, T_CONVMIX, T_LN, T_PCVT, T_WCVT };
struct Op { int type, sync, n0, n1; const void *a0, *a1, *a2, *a3, *a4; void *o0, *o1, *o2; };

__device__ __forceinline__ int n_mixer_steps(int kind) { return kind == 2 ? 2 : 6; }
__device__ __forceinline__ void decode(const Args& a, int i, int s, Op& op) {
    unsigned char* ws = a.ws;
    const int j = i / 3, kind = i % 3, nm = n_mixer_steps(kind);
    bf16_t* W = (bf16_t*)(ws + ((i & 1) ? WS_WSET1 : WS_WSET0));
    bf16_t* B0 = (bf16_t*)(ws + WS_B0); bf16_t* B1 = (bf16_t*)(ws + WS_B1); bf16_t* BIG = (bf16_t*)(ws + WS_BIG); bf16_t* AUX = (bf16_t*)(ws + WS_AUX); bf16_t* PP = (bf16_t*)(ws + WS_PP);
    float* XR = a.out; float* CS = (float*)(ws + WS_CS); float* GLR = (float*)(ws + WS_GLR);
    op.type = T_NOP; op.sync = 1; op.n0 = 0; op.n1 = 0; op.a0 = op.a1 = op.a2 = op.a3 = op.a4 = nullptr; op.o0 = op.o1 = op.o2 = nullptr;
    if (s < nm) {
        if (kind == 0) {
            bf16_t* PROJ = BIG; float* L = (float*)(ws + WS_BIG + 96 * MiB); bf16_t* ST = AUX; float* SC = (float*)(ws + WS_PP + 16 * MiB);
            switch (s) {
            case 0: op.type = T_GEMM_BF16; op.sync = 0; op.a0 = B0; op.a1 = W + WO_IN; op.n0 = 3072; op.n1 = D; op.o0 = PROJ; break;
            case 1: op.type = T_GLR; op.a0 = B0; op.a1 = (const float*)a.in[3] + (size_t)j * D * GLA_IN; op.o0 = GLR; break;
            case 2: op.type = T_GLA_L; op.a0 = GLR; op.a1 = (const float*)a.in[4] + (size_t)j * GRANK * GHK; op.a2 = (const float*)a.in[5] + (size_t)j * GHK; op.o0 = L; break;
            case 3: op.type = T_GLA_STATE; op.a0 = PROJ; op.a1 = L; op.o0 = ST; break;
            case 4: op.type = T_GLA_SCORES; op.a0 = PROJ; op.a1 = L; op.o0 = SC; break;
            default: op.type = T_GLA_OUTNORM; op.a0 = PROJ; op.a1 = L; op.a2 = SC; op.a3 = ST; op.a4 = (const float*)a.in[6] + (size_t)j * GDV; op.o0 = B1; break;
            }
        } else if (kind == 1) {
            bf16_t* Cb = AUX; bf16_t* cqn = AUX + (size_t)12 * MiB; bf16_t* ckvn = AUX + (size_t)16 * MiB; bf16_t* kr = AUX + (size_t)20 * MiB;
            bf16_t* q = BIG; bf16_t* kv = BIG + (size_t)24 * MiB;
            switch (s) {
            case 0: op.type = T_GEMM_BF16; op.a0 = B0; op.a1 = W + WO_IN; op.n0 = MLA_INP; op.n1 = D; op.o0 = Cb; break;
            case 1: op.type = T_MLA_PREP; op.a0 = Cb; op.a1 = (const float*)a.in[9] + j * 256; op.a2 = (const float*)a.in[10] + j * 256; op.a3 = CS; op.o0 = cqn; op.o1 = ckvn; op.o2 = kr; break;
            case 2: op.type = T_GEMM_BF16; op.sync = 0; op.a0 = cqn; op.a1 = W + WO_UQ; op.n0 = 1536; op.n1 = 256; op.o0 = q; break;
            case 3: op.type = T_GEMM_BF16; op.a0 = ckvn; op.a1 = W + WO_UKV; op.n0 = 2048; op.n1 = 256; op.o0 = kv; break;
            case 4: op.type = T_MLA_QROPE; op.a0 = CS; op.o0 = q; break;
            default: op.type = T_MLA_ATTN; op.a0 = q; op.a1 = kv; op.a2 = kr; op.o0 = B1; break;
            }
        } else {
            if (s == 0) { op.type = T_GEMM_BF16; op.a0 = B0; op.a1 = W + WO_IN; op.n0 = 3 * D; op.n1 = D; op.o0 = BIG; }
            else { op.type = T_CONVMIX; op.a0 = BIG; op.a1 = (const float*)a.in[15] + (size_t)j * 3 * D; op.o0 = B1; }
        }
    } else {
        switch (s - nm) {
        case 0: op.type = T_GEMM_RES; op.a0 = B1; op.a1 = W + WO_OUT; op.n0 = D; op.n1 = D; op.a2 = (i == 0) ? (const float*)a.in[0] : XR; op.o0 = XR; break;
        case 1: op.type = T_LN; op.sync = 0; op.a0 = (const float*)a.in[17] + (size_t)(2 * i) * D; op.a1 = (const float*)a.in[18] + (size_t)(2 * i) * D; op.o0 = XR; op.o1 = B0; break;
        case 2: op.type = T_PCVT; op.sync = 0; op.a0 = (const float*)a.in[1] + (size_t)i * M * PLE; op.o0 = AUX; break;
        case 3: op.type = (i + 1 < DEPTH) ? T_WCVT : T_NOP; op.n0 = i + 1; op.o0 = ws + (((i + 1) & 1) ? WS_WSET1 : WS_WSET0); break;
        case 4: op.type = T_GEMM_RELU2; op.sync = 0; op.a0 = B0; op.a1 = W + WO_W1; op.n0 = FF; op.n1 = D; op.o0 = BIG; break;
        case 5: op.type = T_GEMM_BF16; op.a0 = AUX; op.a1 = W + WO_P; op.n0 = D; op.n1 = PLE; op.o0 = PP; break;
        case 6: op.type = T_GEMM_RES; op.a0 = BIG; op.a1 = W + WO_W2; op.n0 = D; op.n1 = FF; op.a2 = XR; op.o0 = XR; break;
        case 7: op.type = T_LN; op.a0 = (const float*)a.in[17] + (size_t)(2 * i + 1) * D; op.a1 = (const float*)a.in[18] + (size_t)(2 * i + 1) * D; op.o0 = XR; op.o1 = B1; break;
        default: op.type = T_GEMM_PLE; op.sync = (i + 1 < DEPTH) ? 1 : 0; op.a0 = B1; op.a1 = W + WO_G; op.n0 = D; op.n1 = D; op.a2 = PP; op.o0 = XR; op.o1 = B0; break;
        }
    }
}

#define RUN_GEMM(EPI_T, ...) do { pg8::Gemm g_{(const bf16_t*)op.a0, (const bf16_t*)op.a1, M, op.n0, op.n1}; pg8::StaticOrder S_; S_.init(M, op.n0, (int)gridDim.x, c.bid); \
    EPI_T E_{__VA_ARGS__}; pg8::gemm_phase<EPI_T, pg8::StaticOrder, true, true>(c.lds, g_, S_, E_); } while (0)

__global__ void __launch_bounds__(NTHREADS, 2) mega_fwd(Args a) {
    extern __shared__ __attribute__((aligned(16))) unsigned char lds_raw[];
    cg::grid_group grid = cg::this_grid();
    for (int i = -1; i < DEPTH; ++i) {
        const int ns = (i < 0) ? 1 : n_mixer_steps(i % 3) + 9;
        for (int s = 0; s < ns; ++s) {
            Ctx c; c.tid = tid_now(); c.bid = bid_now(); c.lane = c.tid & 63; c.wave = __builtin_amdgcn_readfirstlane(c.tid >> 6); c.gw = c.bid * NWAVES + c.wave; c.ngw = gridDim.x * NWAVES; c.lds = (LAS unsigned char*)lds_raw;
            Op op;
            if (i < 0) { op.type = T_PROLOGUE; op.sync = 1; op.n0 = op.n1 = 0; op.a0 = op.a1 = op.a2 = op.a3 = op.a4 = nullptr; op.o0 = op.o1 = op.o2 = nullptr; }
            else decode(a, i, s, op);
            switch (op.type) {
            case T_PROLOGUE: {
                const int* pos = (const int*)a.in[2]; float* CS = (float*)(a.ws + WS_CS);
                for (size_t e = (size_t)c.bid * NTHREADS + c.tid; e < (size_t)M * 32; e += (size_t)gridDim.x * NTHREADS) {
                    const int jj = (int)(e & 31); const size_t m = e >> 5; const float ang = (float)pos[m] * inv_freq(jj);
                    float sn_, cs_; sincosf(ang, &sn_, &cs_); CS[m * 64 + jj] = cs_; CS[m * 64 + 32 + jj] = sn_;
                }
                cvt_rows(c, (const float*)a.in[0], (bf16_t*)(a.ws + WS_B0), (size_t)M * D);
                convert_weights(c, a, 0, (bf16_t*)(a.ws + WS_WSET0));
            } break;
            case T_GEMM_BF16: RUN_GEMM(pg8::EpiBf16<0>, (bf16_t*)op.o0, op.n0); break;
            case T_GEMM_RELU2: RUN_GEMM(pg8::EpiBf16<2>, (bf16_t*)op.o0, op.n0); break;
            case T_GEMM_RES: RUN_GEMM(pg8::EpiRes, (const float*)op.a2, (float*)op.o0, D, ALPHA); break;
            case T_GEMM_PLE: RUN_GEMM(pg8::EpiPle, (const float*)op.o0, (float*)op.o0, (const bf16_t*)op.a2, (bf16_t*)op.o1, D); break;
            case T_GLR: gla_glr<bf16_t>((const bf16_t*)op.a0, (const float*)op.a1, (float*)op.o0, M); break;
            case T_GLA_L: gla_L<float>((const float*)op.a0, GRANK, (const float*)op.a1, (const float*)op.a2, (float*)op.o0, M); break;
            case T_GLA_STATE: gla_state<bf16_t, bf16_t>((const bf16_t*)op.a0 + 512, 3072, (const bf16_t*)op.a0 + 1024, 3072, (const float*)op.a1, (bf16_t*)op.o0, NB); break;
            case T_GLA_SCORES: gla_scores<bf16_t>((const bf16_t*)op.a0, 3072, (const bf16_t*)op.a0 + 512, 3072, (const float*)op.a1, (float*)op.o0, NB); break;
            case T_GLA_OUTNORM: gla_out_norm<bf16_t, bf16_t, bf16_t>((const bf16_t*)op.a0, 3072, (const bf16_t*)op.a0 + 1024, 3072, (const bf16_t*)op.a0 + 2048, 3072, (const float*)op.a1, (const float*)op.a2, (const bf16_t*)op.a3, (const float*)op.a4, (bf16_t*)op.o0, M); break;
            case T_MLA_PREP: mla_prep<bf16_t, bf16_t>((const bf16_t*)op.a0, MLA_INP, (const float*)op.a1, (const float*)op.a2, (const float*)op.a3, (bf16_t*)op.o0, (bf16_t*)op.o1, (bf16_t*)op.o2, M); break;
            case T_MLA_QROPE: mla_qrope<bf16_t>((bf16_t*)op.o0, (const float*)op.a0, M); break;
            case T_MLA_ATTN: mla_attn<bf16_t, bf16_t>((const bf16_t*)op.a0, (const bf16_t*)op.a1, (const bf16_t*)op.a2, (bf16_t*)op.o0, NB, (float*)lds_raw + c.wave * S); break;
            case T_CONVMIX: conv_mix<bf16_t, bf16_t>((const bf16_t*)op.a0, 3 * D, (const float*)op.a1, (bf16_t*)op.o0, M); break;
            case T_LN: ln_pass(c, (float*)op.o0, (const float*)op.a0, (const float*)op.a1, (bf16_t*)op.o1); break;
            case T_PCVT: cvt_rows(c, (const float*)op.a0, (bf16_t*)op.o0, (size_t)M * PLE); break;
            case T_WCVT: convert_weights(c, a, op.n0, (bf16_t*)op.o0); break;
            default: break;
            }
            if (op.sync) grid.sync();
        }
    }
}

extern "C" void kernel_launch(void* const* d_in, const int* in_sizes, int n_in, void* d_out, int out_size, void* d_ws, size_t ws_size, hipStream_t stream) {
    static int grid = 0;
    if (grid == 0) {
        if (n_in != 23 || out_size != M * D || ws_size < WS_END) { fprintf(stderr, "kernel_launch: unexpected shapes/workspace (n_in %d out %d ws %zu need %zu)\n", n_in, out_size, ws_size, (size_t)WS_END); grid = -1; return; }
        int dev = 0, cus = 0, per_cu = 0;
        (void)hipGetDevice(&dev); (void)hipDeviceGetAttribute(&cus, hipDeviceAttributeMultiprocessorCount, dev);
        if (hipFuncSetAttribute((const void*)mega_fwd, hipFuncAttributeMaxDynamicSharedMemorySize, LDS_BYTES) != hipSuccess) { fprintf(stderr, "kernel_launch: hipFuncSetAttribute failed\n"); grid = -1; return; }
        (void)hipOccupancyMaxActiveBlocksPerMultiprocessor(&per_cu, (const void*)mega_fwd, NTHREADS, LDS_BYTES);
        if (per_cu < 1) { fprintf(stderr, "kernel_launch: occupancy query says %d blocks per CU\n", per_cu); grid = -1; return; }
        grid = cus;
    }
    if (grid < 0) return;
    Args a{};
    for (int i = 0; i < 23; ++i) a.in[i] = d_in[i];
    a.out = (float*)d_out; a.ws = (unsigned char*)d_ws;
    void* args[] = {&a};
    hipError_t e = hipLaunchCooperativeKernel((const void*)mega_fwd, dim3(grid), dim3(NTHREADS), args, LDS_BYTES, stream);
    if (e != hipSuccess) fprintf(stderr, "cooperative launch failed: %s (grid %d)\n", hipGetErrorString(e), grid);
}
```

```cpp
#include <hip/hip_runtime.h>
#include <hip/hip_cooperative_groups.h>
#include <cstdint>
#include <cstdio>
namespace cg = cooperative_groups;

constexpr int NB = 8, S = 2048, D = 1024, M = NB * S, DEPTH = 4, CH = 64, NCH = S / CH;
constexpr int FF = 4096, PLE = 256;
constexpr int GLA_IN = 3088, GH = 4, GDK = 128, GDV = 256, GHK = 512, GHV = 1024, GRANK = 16;
constexpr int MLA_IN = 576, MLA_INP = 768, MH = 8, MNOPE = 128, MROPE = 64, MV = 128, MQK = 192;
constexpr float ALPHA = 1.6817928305074290860622509524664f;
constexpr float LN_EPS = 1e-5f, RMS_EPS = 1e-6f;

#define LAS __attribute__((address_space(3)))
typedef unsigned short bf16_t;
__device__ __forceinline__ float ldf(const float* p, size_t i) { return p[i]; }
__device__ __forceinline__ float ldf(const bf16_t* p, size_t i) { return __uint_as_float(((unsigned)p[i]) << 16); }
__device__ __forceinline__ unsigned f2bf(float f) { unsigned u = __float_as_uint(f); return (u + 0x7fffu + ((u >> 16) & 1u)) >> 16; }
__device__ __forceinline__ unsigned pk2(float lo, float hi) { return f2bf(lo) | (f2bf(hi) << 16); }
__device__ __forceinline__ float bflo(unsigned w) { return __uint_as_float(w << 16); }
__device__ __forceinline__ float bfhi(unsigned w) { return __uint_as_float(w & 0xffff0000u); }
__device__ __forceinline__ void stf(float* p, size_t i, float v) { p[i] = v; }
__device__ __forceinline__ void stf(bf16_t* p, size_t i, float v) { p[i] = (bf16_t)f2bf(v); }
__device__ __forceinline__ float wave_sum(float v) {
#pragma unroll
    for (int o = 1; o < 64; o <<= 1) v += __shfl_xor(v, o);
    return v;
}
__device__ __forceinline__ float wave_max(float v) {
#pragma unroll
    for (int o = 1; o < 64; o <<= 1) v = fmaxf(v, __shfl_xor(v, o));
    return v;
}
__device__ __forceinline__ float log_sigmoid(float z) { return fminf(z, 0.f) - log1pf(expf(-fabsf(z))); }
__device__ __forceinline__ float sigmoidf_(float z) { return 1.f / (1.f + expf(-z)); }
__device__ const float INV_FREQ[32] = {1.0f, 0.7498942017555237f, 0.5623413324356079f, 0.4216965138912201f, 0.3162277638912201f, 0.23713737726211548f, 0.17782793939113617f, 0.1333521455526352f, 0.10000000149011612f, 0.0749894231557846f, 0.05623413249850273f, 0.04216964915394783f, 0.03162277489900589f, 0.023713737726211548f, 0.017782794311642647f, 0.013335213996469975f, 0.009999999776482582f, 0.007498942315578461f, 0.005623413249850273f, 0.0042169648222625256f, 0.003162277629598975f, 0.0023713738191872835f, 0.0017782794311642647f, 0.0013335214462131262f, 0.0010000000474974513f, 0.0007498941849917173f, 0.000562341301701963f, 0.0004216965171508491f, 0.0003162277571391314f, 0.00023713737027719617f, 0.00017782794020604342f, 0.0001333521504420787f};
__device__ __forceinline__ float inv_freq(int j) { return INV_FREQ[j]; }

constexpr int NTHR = 512;
__device__ __forceinline__ int tid_now() { int t = threadIdx.x; asm volatile("" : "+v"(t)); return t; }
__device__ __forceinline__ int bid_now() { int b = blockIdx.x; asm volatile("" : "+s"(b)); return b; }
#define GSTRIDE(i, n) for (size_t i = (size_t)bid_now() * NTHR + tid_now(), _st = (size_t)gridDim.x * NTHR; i < (size_t)(n); i += _st)
#define WSTRIDE_DECL const int _t = tid_now(); const int lane = _t & 63; const size_t gw = ((size_t)bid_now() * NTHR + _t) >> 6, nw = ((size_t)gridDim.x * NTHR) >> 6

template <class T> __device__ __forceinline__ void gla_glr(const T* xb, const float* Win, float* glr, int Mloc) {
    WSTRIDE_DECL;
    for (size_t m = gw; m < (size_t)Mloc; m += nw) {
        float acc[GRANK];
#pragma unroll
        for (int r = 0; r < GRANK; ++r) acc[r] = 0.f;
        for (int i = 0; i < D / 64; ++i) { const int k = lane + 64 * i; const float xv = ldf(xb, m * D + k); const float* w = Win + (size_t)k * GLA_IN + 3072;
#pragma unroll
            for (int r = 0; r < GRANK; ++r) acc[r] += xv * w[r]; }
#pragma unroll
        for (int r = 0; r < GRANK; ++r) { const float s = wave_sum(acc[r]); if (lane == r) glr[m * GRANK + r] = s; }
    }
}
template <class T> __device__ __forceinline__ void gla_L(const T* glr, int ldg, const float* wgu, const float* bg, float* L, int Mloc) {
    GSTRIDE(idx, (size_t)(Mloc / CH) * GHK) {
        const int ch = (int)(idx % GHK); const int cn = (int)(idx / GHK);
        float acc = 0.f;
        for (int t = 0; t < CH; ++t) {
            const size_t m = (size_t)cn * CH + t; float z = bg[ch];
            for (int r = 0; r < GRANK; ++r) z += ldf(glr, m * ldg + r) * wgu[r * GHK + ch];
            acc += log_sigmoid(z) * (1.f / 16.f);
            L[m * GHK + ch] = acc;
        }
    }
}
template <class T, class TO> __device__ __forceinline__ void gla_state(const T* k, int ldk, const T* v, int ldv, const float* L, TO* ST, int nb) {
    GSTRIDE(idx, (size_t)nb * GH * GDK * GDV) {
        const int dv = (int)(idx % GDV), dk = (int)((idx / GDV) % GDK), h = (int)((idx / (GDV * GDK)) % GH), b = (int)(idx / ((size_t)GDV * GDK * GH));
        float st = 0.f;
        for (int n = 0; n < NCH; ++n) {
            stf(ST, (((size_t)(b * GH + h) * NCH + n) * GDK + dk) * GDV + dv, st);
            const size_t m0 = (size_t)b * S + n * CH;
            const float Lend = L[(m0 + CH - 1) * GHK + h * GDK + dk];
            float acc = 0.f;
            for (int s = 0; s < CH; ++s) { const size_t m = m0 + s; acc += ldf(k, m * ldk + h * GDK + dk) * expf(Lend - L[m * GHK + h * GDK + dk]) * ldf(v, m * ldv + h * GDV + dv); }
            st = expf(Lend) * st + acc;
        }
    }
}
template <class T> __device__ __forceinline__ void gla_scores(const T* q, int ldq, const T* k, int ldk, const float* L, float* SC, int nb) {
    GSTRIDE(idx, (size_t)nb * GH * NCH * CH * CH) {
        const int s = (int)(idx % CH), t = (int)((idx / CH) % CH); const size_t unit = idx / (CH * CH);
        const int n = (int)(unit % NCH), h = (int)((unit / NCH) % GH), b = (int)(unit / (NCH * GH));
        const size_t mt = (size_t)b * S + n * CH + t, ms = (size_t)b * S + n * CH + s;
        float acc = 0.f;
        for (int d = 0; d < GDK; ++d) acc += ldf(q, mt * ldq + h * GDK + d) * ldf(k, ms * ldk + h * GDK + d) * expf(-fabsf(L[mt * GHK + h * GDK + d] - L[ms * GHK + h * GDK + d]));
        SC[idx] = acc * 0.088388347648318440550f;
    }
}
template <class T, class TS, class TO> __device__ __forceinline__ void gla_out_norm(const T* q, int ldq, const T* v, int ldv, const T* r, int ldr, const float* L, const float* SC, const TS* ST, const float* g, TO* OG, int Mloc) {
    WSTRIDE_DECL;
    for (size_t it = gw; it < (size_t)Mloc * GH; it += nw) {
        const size_t m = it / GH; const int h = (int)(it % GH);
        const int b = (int)(m / S), tt = (int)(m % S), n = tt / CH, t = tt % CH;
        const size_t unit = (size_t)(b * GH + h) * NCH + n, m0 = (size_t)b * S + n * CH;
        float o[4] = {0.f, 0.f, 0.f, 0.f};
        for (int s = 0; s < CH; ++s) { const float sc = SC[(unit * CH + t) * CH + s];
#pragma unroll
            for (int j = 0; j < 4; ++j) o[j] += sc * ldf(v, (m0 + s) * ldv + h * GDV + lane + 64 * j); }
        float o2[4] = {0.f, 0.f, 0.f, 0.f};
        for (int dk = 0; dk < GDK; ++dk) { const float qe = ldf(q, m * ldq + h * GDK + dk) * expf(L[m * GHK + h * GDK + dk]);
#pragma unroll
            for (int j = 0; j < 4; ++j) o2[j] += qe * ldf(ST, (unit * GDK + dk) * GDV + lane + 64 * j); }
        float ss = 0.f;
#pragma unroll
        for (int j = 0; j < 4; ++j) { o[j] += o2[j] * 0.088388347648318440550f; ss += o[j] * o[j]; }
        const float rstd = rsqrtf(wave_sum(ss) * (1.f / GDV) + RMS_EPS);
#pragma unroll
        for (int j = 0; j < 4; ++j) { const int dv = lane + 64 * j; const float rv = ldf(r, m * ldr + h * GDV + dv); stf(OG, m * GHV + h * GDV + dv, o[j] * rstd * g[dv] * (rv * sigmoidf_(rv))); }
    }
}
template <class T, class TO> __device__ __forceinline__ void mla_prep(const T* Cb, int ldc, const float* qn, const float* kvn, const float* cs, TO* cqn, TO* ckvn, TO* kr, int Mloc) {
    WSTRIDE_DECL;
    for (size_t m = gw; m < (size_t)Mloc; m += nw) {
        float a[4], c[4], sa = 0.f, sc = 0.f;
#pragma unroll
        for (int j = 0; j < 4; ++j) { a[j] = ldf(Cb, m * ldc + lane + 64 * j); c[j] = ldf(Cb, m * ldc + 256 + lane + 64 * j); sa += a[j] * a[j]; sc += c[j] * c[j]; }
        const float ra = rsqrtf(wave_sum(sa) * (1.f / 256.f) + RMS_EPS), rc = rsqrtf(wave_sum(sc) * (1.f / 256.f) + RMS_EPS);
#pragma unroll
        for (int j = 0; j < 4; ++j) { const int d = lane + 64 * j; stf(cqn, m * 256 + d, a[j] * ra * qn[d]); stf(ckvn, m * 256 + d, c[j] * rc * kvn[d]); }
        if (lane < 32) {
            const float x1 = ldf(Cb, m * ldc + 512 + lane), x2 = ldf(Cb, m * ldc + 544 + lane);
            const float csn = cs[m * 64 + lane], sn = cs[m * 64 + 32 + lane];
            stf(kr, m * 64 + lane, x1 * csn - x2 * sn); stf(kr, m * 64 + 32 + lane, x2 * csn + x1 * sn);
        }
    }
}
template <class T> __device__ __forceinline__ void mla_qrope(T* q, const float* cs, int Mloc) {
    GSTRIDE(idx, (size_t)Mloc * MH * 32) {
        const int j = (int)(idx % 32), h = (int)((idx / 32) % MH); const size_t m = idx / (32 * MH);
        const size_t o = m * (MH * MQK) + h * MQK + MNOPE + j;
        const float x1 = ldf(q, o), x2 = ldf(q, o + 32);
        const float csn = cs[m * 64 + j], sn = cs[m * 64 + 32 + j];
        stf(q, o, x1 * csn - x2 * sn); stf(q, o + 32, x2 * csn + x1 * sn);
    }
}
template <class T, class TO> __device__ __forceinline__ void mla_attn(const T* q, const T* kv, const T* kr, TO* o, int nb, float* sc) {
    WSTRIDE_DECL;
    for (size_t it = gw; it < (size_t)nb * MH * S; it += nw) {
        const int qi = (int)(it % S), h = (int)((it / S) % MH), b = (int)(it / ((size_t)S * MH));
        const size_t m = (size_t)b * S + qi; const int lim = (qi / CH + 1) * CH;
        const T* qp = q + m * (MH * MQK) + h * MQK;
        float mx = -INFINITY;
        for (int s = lane; s < lim; s += 64) {
            const size_t ms = (size_t)b * S + s; const T* kp = kv + ms * (MH * 256) + h * 256; const T* rp = kr + ms * 64;
            float dot = 0.f;
            for (int d = 0; d < MNOPE; ++d) dot += ldf(qp, d) * ldf(kp, d);
            for (int j = 0; j < MROPE; ++j) dot += ldf(qp, MNOPE + j) * ldf(rp, j);
            dot *= 0.072168783648703220564f;
            sc[s] = dot; mx = fmaxf(mx, dot);
        }
        mx = wave_max(mx);
        float sum = 0.f;
        for (int s = lane; s < lim; s += 64) { const float p = expf(sc[s] - mx); sc[s] = p; sum += p; }
        sum = wave_sum(sum);
        __builtin_amdgcn_s_waitcnt(0); __builtin_amdgcn_wave_barrier();
        float a0 = 0.f, a1 = 0.f;
        for (int s = 0; s < lim; ++s) { const size_t ms = (size_t)b * S + s; const float p = sc[s]; a0 += p * ldf(kv, ms * (MH * 256) + h * 256 + 128 + lane); a1 += p * ldf(kv, ms * (MH * 256) + h * 256 + 192 + lane); }
        const float inv = 1.f / sum;
        stf(o, m * (MH * MV) + h * MV + lane, a0 * inv); stf(o, m * (MH * MV) + h * MV + 64 + lane, a1 * inv);
        __builtin_amdgcn_s_waitcnt(0); __builtin_amdgcn_wave_barrier();
    }
}
template <class T, class TO> __device__ __forceinline__ void conv_mix(const T* bcu, int ld, const float* cw, TO* a, int Mloc) {
    GSTRIDE(idx, (size_t)Mloc * D) {
        const int c = (int)(idx % D); const size_t m = idx / D; const int t = (int)(m % S);
        float z = 0.f;
#pragma unroll
        for (int j = 0; j < 3; ++j) { const int dt = 2 - j; if (t - dt >= 0) { const size_t mm = m - dt; z += cw[j * D + c] * ldf(bcu, mm * ld + D + c) * ldf(bcu, mm * ld + 2 * D + c); } }
        stf(a, idx, ldf(bcu, m * ld + c) * z);
    }
}
namespace pg8 {
#define PG8_LAS __attribute__((address_space(3)))
typedef unsigned short bf16_t;
typedef short bf16x8 __attribute__((ext_vector_type(8)));
typedef float f32x4 __attribute__((ext_vector_type(4)));
typedef unsigned u32x4 __attribute__((ext_vector_type(4)));
constexpr int BM = 256, BK = 64, HALF = 128, HTB = HALF * BK * 2  , STAGE_BYTES = 8 * HTB, NXCD = 8, WGM = 8;

__host__ __device__ __forceinline__ int lds_byte(int r, int c) { const int st = (r >> 4) * 2 + (c >> 5), rr = r & 15, cc = c & 31, ob = rr * 64 + cc * 2; return st * 1024 + (ob ^ (((ob >> 9) & 1) << 5)); }
__host__ __device__ __forceinline__ void stage_rc(int b, int& R, int& C) { const int st = b / 1024, sb = b % 1024, swz = sb ^ (((sb >> 9) & 1) << 5); R = (st >> 1) * 16 + swz / 64; C = (st & 1) * 32 + (swz % 64) / 2; }
__host__ __device__ __forceinline__ int perm32(int rho) { const int n = rho >> 4, i = rho & 15; return 8 * (i >> 2) + 4 * n + (i & 3); }

struct Unit { int pm, pn; };
struct Gemm { const bf16_t* A; const bf16_t* Bt; int M, N, K; };

struct StaticOrder {
    int nM, nN, nwg, G, c;
    __host__ __device__ void init(int M, int N, int G_, int c_) { nM = M / BM; nN = N / BM; nwg = nM * nN; G = G_; c = c_; }
    __host__ __device__ bool next(int i, Unit& u) const {
        const long L = (long)i * G + c; if (L >= nwg) return false;
        int wgid = (int)L; { const int q = nwg / NXCD, r = nwg % NXCD, xcd = wgid % NXCD, off = wgid / NXCD; wgid = (xcd < r ? xcd * (q + 1) : r * (q + 1) + (xcd - r) * q) + off; }
        const int nig = WGM * nN, gid = wgid / nig, fm = gid * WGM, gsz = (nM - fm) < WGM ? (nM - fm) : WGM;
        u.pm = fm + ((wgid % nig) % gsz); u.pn = (wgid % nig) / gsz; return true;
    }
    __device__ __forceinline__ void a_ready(const Unit&) const {}
    __device__ __forceinline__ void done(const Unit&) const {}
};


__device__ __forceinline__ unsigned cvt_pk_bf16(float lo, float hi) { unsigned r; asm volatile("v_cvt_pk_bf16_f32 %0, %1, %2" : "=v"(r) : "v"(lo), "v"(hi)); return r; }
typedef unsigned u32x2 __attribute__((ext_vector_type(2)));
template <int ACT  > struct EpiBf16 {
    static constexpr bool PERM = true, AFTER_DRAIN = false;
    bf16_t* O; int ldc;
    __device__ __forceinline__ void operator()(const f32x4 (&acc)[2][2][4][2], const Unit& u, int wr, int wc, int fr, int fq) const {
        const int row0 = u.pm * BM + wr * 64 + fr, col0 = u.pn * BM + wc * 32 + 8 * fq;
#pragma unroll
        for (int ai = 0; ai < 2; ++ai)
#pragma unroll
            for (int m = 0; m < 4; ++m) { bf16_t* rowp = O + (size_t)(row0 + ai * HALF + m * 16) * ldc + col0;
#pragma unroll
                for (int bj = 0; bj < 2; ++bj) { f32x4 v0 = acc[ai][bj][m][0], v1 = acc[ai][bj][m][1];
                    if (ACT == 2) {
#pragma unroll
                        for (int e = 0; e < 4; ++e) { float a = fmaxf(v0[e], 0.f); v0[e] = a * a; float b = fmaxf(v1[e], 0.f); v1[e] = b * b; } }
                    u32x4 w; w.x = cvt_pk_bf16(v0[0], v0[1]); w.y = cvt_pk_bf16(v0[2], v0[3]); w.z = cvt_pk_bf16(v1[0], v1[1]); w.w = cvt_pk_bf16(v1[2], v1[3]);
                    *(u32x4*)(rowp + bj * HALF) = w; } }
    }
};
struct EpiRes {
    static constexpr bool PERM = false, AFTER_DRAIN = false;
    const float* base; float* out; int ldc; float alpha;
    __device__ __forceinline__ void operator()(const f32x4 (&acc)[2][2][4][2], const Unit& u, int wr, int wc, int fr, int fq) const {
        const int col0 = u.pn * BM + wc * 32 + 4 * fq;
#pragma unroll
        for (int ai = 0; ai < 2; ++ai)
#pragma unroll
            for (int m = 0; m < 4; ++m) { const size_t off = (size_t)(u.pm * BM + ai * HALF + wr * 64 + m * 16 + fr) * ldc + col0;
#pragma unroll
                for (int bj = 0; bj < 2; ++bj)
#pragma unroll
                    for (int n = 0; n < 2; ++n) { const f32x4 bs = *(const f32x4*)(base + off + bj * HALF + n * 16); *(f32x4*)(out + off + bj * HALF + n * 16) = bs * alpha + acc[ai][bj][m][n]; } }
    }
};
struct EpiPle {
    static constexpr bool PERM = false, AFTER_DRAIN = false;
    const float* xin; float* xout; const bf16_t* P; bf16_t* xb; int ldc;
    __device__ __forceinline__ void operator()(const f32x4 (&acc)[2][2][4][2], const Unit& u, int wr, int wc, int fr, int fq) const {
        const int col0 = u.pn * BM + wc * 32 + 4 * fq;
#pragma unroll
        for (int ai = 0; ai < 2; ++ai)
#pragma unroll
            for (int m = 0; m < 4; ++m) { const size_t off = (size_t)(u.pm * BM + ai * HALF + wr * 64 + m * 16 + fr) * ldc + col0;
#pragma unroll
                for (int bj = 0; bj < 2; ++bj)
#pragma unroll
                    for (int n = 0; n < 2; ++n) { const size_t o = off + bj * HALF + n * 16; const f32x4 x2 = *(const f32x4*)(xin + o); const u32x2 pw = *(const u32x2*)(P + o); const f32x4 a = acc[ai][bj][m][n];
                        f32x4 r; r[0] = x2[0] + __uint_as_float(pw.x << 16) / (1.f + __expf(-a[0])); r[1] = x2[1] + __uint_as_float(pw.x & 0xffff0000u) / (1.f + __expf(-a[1]));
                        r[2] = x2[2] + __uint_as_float(pw.y << 16) / (1.f + __expf(-a[2])); r[3] = x2[3] + __uint_as_float(pw.y & 0xffff0000u) / (1.f + __expf(-a[3]));
                        *(f32x4*)(xout + o) = r; u32x2 w; w.x = cvt_pk_bf16(r[0], r[1]); w.y = cvt_pk_bf16(r[2], r[3]); *(u32x2*)(xb + o) = w; } }
    }
};
template <class Epi, class Sched, bool ALIGN_EPI = false, bool SP2 = false>
__device__ __forceinline__ void gemm_phase(PG8_LAS unsigned char* lds, const Gemm g, const Sched& S, const Epi& E) {
    const int tid = tid_now(), wid = __builtin_amdgcn_readfirstlane(tid >> 6), lane = tid & 63, wr = wid >> 2, wc = wid & 3, fr = lane & 15, fq = lane >> 4;
    const int K = g.K, nt = K / BK;
    unsigned voffA[2], voffB[2];
#pragma unroll
    for (int i = 0; i < 2; ++i) { int R, C; stage_rc(tid * 16 + i * 8192, R, C); const int Rb = Epi::PERM ? ((R & ~31) + perm32(R & 31)) : R;
        voffA[i] = (unsigned)(R * K + C) * 2u; voffB[i] = (unsigned)(Rb * K + C) * 2u; }
    const size_t kstep = (size_t)(BK * 2);
    const size_t hstep = (size_t)HALF * K * 2;
    const size_t tstep = 2 * hstep;
    const unsigned ldsw = (unsigned)wid * 1024u;
    const int aoff = lds_byte(wr * 64 + fr, fq * 8), boff = lds_byte(wc * 32 + fr, fq * 8);
#define PG8_SA(b, h) (((b) * 2 + (h)) * HTB)
#define PG8_SB(b, h) ((4 + (b) * 2 + (h)) * HTB)
#define PG8_STAGE(bufoff, gbase, voff) do { _Pragma("unroll") for (int _i = 0; _i < 2; ++_i) \
        __builtin_amdgcn_global_load_lds((const unsigned*)((const char*)(gbase) + (voff)[_i]), (PG8_LAS unsigned*)(lds + (bufoff) + ldsw + _i * 8192), 16, 0, 0); } while (0)
#define PG8_LDA(dst, b, h) do { _Pragma("unroll") for (int m = 0; m < 4; ++m) _Pragma("unroll") for (int k = 0; k < 2; ++k) dst[m][k] = *(const PG8_LAS bf16x8*)(lds + PG8_SA(b, h) + aoff + m * 2048 + k * 1024); } while (0)
#define PG8_LDB(dst, b, h) do { _Pragma("unroll") for (int n = 0; n < 2; ++n) _Pragma("unroll") for (int k = 0; k < 2; ++k) dst[n][k] = *(const PG8_LAS bf16x8*)(lds + PG8_SB(b, h) + boff + n * 2048 + k * 1024); } while (0)
#define PG8_MMA(ai, bj, At, Bt) do { __builtin_amdgcn_s_setprio(1); _Pragma("unroll") for (int m = 0; m < 4; ++m) _Pragma("unroll") for (int n = 0; n < 2; ++n) _Pragma("unroll") for (int k = 0; k < 2; ++k) \
        acc[ai][bj][m][n] = __builtin_amdgcn_mfma_f32_16x16x32_bf16(Bt[n][k], At[m][k], acc[ai][bj][m][n], 0, 0, 0); __builtin_amdgcn_s_setprio(0); } while (0)
#define PG8_WAIT_V(n) asm volatile("s_waitcnt vmcnt(" #n ")" ::: "memory")
#define PG8_WAIT_L(n) asm volatile("s_waitcnt lgkmcnt(" #n ")" ::: "memory")
#define PG8_BAR __builtin_amdgcn_s_barrier()
#define PG8_SCHED __builtin_amdgcn_sched_barrier(0)
    Unit cur, nxt; int ui = 0;
    if (!S.next(0, cur)) return;
    f32x4 acc[2][2][4][2];
#pragma unroll
    for (int a = 0; a < 2; ++a)
#pragma unroll
        for (int b = 0; b < 2; ++b)
#pragma unroll
            for (int m = 0; m < 4; ++m)
#pragma unroll
                for (int n = 0; n < 2; ++n) acc[a][b][m][n] = (f32x4){0.f, 0.f, 0.f, 0.f};
    bf16x8 At[4][2], B0[2][2], B1[2][2];
    const char* cA = (const char*)g.A + (size_t)cur.pm * tstep; const char* cB = (const char*)g.Bt + (size_t)cur.pn * tstep;
    S.a_ready(cur);
    if constexpr (SP2) {
        PG8_STAGE(PG8_SB(0, 0), cB, voffB); PG8_STAGE(PG8_SB(0, 1), cB + hstep, voffB); PG8_STAGE(PG8_SA(0, 0), cA, voffA); PG8_STAGE(PG8_SA(0, 1), cA + hstep, voffA);
        if (wr == 1) PG8_BAR;
        PG8_WAIT_V(2); PG8_BAR;
        PG8_STAGE(PG8_SB(1, 0), cB + kstep, voffB); PG8_STAGE(PG8_SA(1, 0), cA + kstep, voffA); PG8_STAGE(PG8_SB(1, 1), cB + hstep + kstep, voffB);
        PG8_WAIT_V(6); PG8_BAR;
    } else {
        PG8_STAGE(PG8_SB(0, 0), cB, voffB); PG8_STAGE(PG8_SA(0, 0), cA, voffA); PG8_STAGE(PG8_SB(0, 1), cB + hstep, voffB); PG8_STAGE(PG8_SA(0, 1), cA + hstep, voffA);
        if (wr == 1) PG8_BAR;
        PG8_WAIT_V(4); PG8_BAR;
        PG8_STAGE(PG8_SB(1, 0), cB + kstep, voffB); PG8_STAGE(PG8_SA(1, 0), cA + kstep, voffA); PG8_STAGE(PG8_SB(1, 1), cB + hstep + kstep, voffB);
        PG8_WAIT_V(6); PG8_BAR;
    }
    for (;;) {
        const bool has_next = S.next(ui + 1, nxt);
        const char* nA = has_next ? (const char*)g.A + (size_t)nxt.pm * tstep : cA; const char* nB = has_next ? (const char*)g.Bt + (size_t)nxt.pn * tstep : cB;
        for (int t = 0; t < nt; t += 2) {
            const bool last = (t == nt - 2);
            const char* a1 = cA + (size_t)(t + 1) * kstep;
            const char* a2 = last ? nA : cA + (size_t)(t + 2) * kstep; const char* b2 = last ? nB : cB + (size_t)(t + 2) * kstep;
            const char* a3 = a2 + kstep; const char* b3 = b2 + kstep;
            if (last && has_next) S.a_ready(nxt);
            if constexpr (SP2) {
            PG8_LDB(B0, 0, 0); PG8_LDB(B1, 0, 1); PG8_SCHED; PG8_LDA(At, 0, 0); PG8_STAGE(PG8_SA(1, 1), a1 + hstep, voffA);
            PG8_WAIT_V(8); PG8_WAIT_L(0); PG8_BAR; PG8_MMA(0, 0, At, B0); PG8_MMA(0, 1, At, B1); PG8_BAR; PG8_SCHED;
            PG8_LDA(At, 0, 1); PG8_STAGE(PG8_SB(0, 0), b2, voffB); PG8_STAGE(PG8_SB(0, 1), b2 + hstep, voffB); PG8_STAGE(PG8_SA(0, 0), a2, voffA);
            PG8_WAIT_V(8); PG8_WAIT_L(0); PG8_BAR; PG8_MMA(1, 0, At, B0); PG8_MMA(1, 1, At, B1); PG8_BAR; PG8_SCHED;
            PG8_LDB(B0, 1, 0); PG8_LDB(B1, 1, 1); PG8_SCHED; PG8_LDA(At, 1, 0); PG8_STAGE(PG8_SA(0, 1), a2 + hstep, voffA);
            PG8_WAIT_V(8); PG8_WAIT_L(0); PG8_BAR; PG8_MMA(0, 0, At, B0); PG8_MMA(0, 1, At, B1); PG8_BAR; PG8_SCHED;
            PG8_LDA(At, 1, 1); PG8_STAGE(PG8_SB(1, 0), b3, voffB); PG8_STAGE(PG8_SB(1, 1), b3 + hstep, voffB); PG8_STAGE(PG8_SA(1, 0), a3, voffA);
            PG8_WAIT_V(8); PG8_WAIT_L(0); PG8_BAR; PG8_MMA(1, 0, At, B0); PG8_MMA(1, 1, At, B1); PG8_BAR; PG8_SCHED;
            } else {
            PG8_LDB(B0, 0, 0); PG8_SCHED; PG8_LDA(At, 0, 0); PG8_STAGE(PG8_SA(1, 1), a1 + hstep, voffA);
            PG8_WAIT_L(8); PG8_BAR; PG8_WAIT_L(0); PG8_MMA(0, 0, At, B0); PG8_BAR; PG8_SCHED;
            PG8_LDB(B1, 0, 1); PG8_STAGE(PG8_SB(0, 0), b2, voffB);
            PG8_BAR; PG8_WAIT_L(0); PG8_MMA(0, 1, At, B1); PG8_BAR;
            PG8_LDA(At, 0, 1); PG8_STAGE(PG8_SA(0, 0), a2, voffA);
            PG8_BAR; PG8_WAIT_L(0); PG8_MMA(1, 0, At, B0); PG8_BAR; PG8_SCHED;
            PG8_STAGE(PG8_SB(0, 1), b2 + hstep, voffB);
            PG8_WAIT_V(6); PG8_BAR; PG8_MMA(1, 1, At, B1); PG8_BAR;
            PG8_LDB(B0, 1, 0); PG8_SCHED; PG8_LDA(At, 1, 0); PG8_STAGE(PG8_SA(0, 1), a2 + hstep, voffA);
            PG8_WAIT_L(8); PG8_BAR; PG8_WAIT_L(0); PG8_MMA(0, 0, At, B0); PG8_BAR; PG8_SCHED;
            PG8_LDB(B1, 1, 1); PG8_STAGE(PG8_SB(1, 0), b3, voffB);
            PG8_BAR; PG8_WAIT_L(0); PG8_MMA(0, 1, At, B1); PG8_BAR;
            PG8_LDA(At, 1, 1); PG8_STAGE(PG8_SA(1, 0), a3, voffA);
            PG8_BAR; PG8_WAIT_L(0); PG8_MMA(1, 0, At, B0); PG8_BAR; PG8_SCHED;
            PG8_STAGE(PG8_SB(1, 1), b3 + hstep, voffB);
            PG8_WAIT_V(6); PG8_BAR; PG8_MMA(1, 1, At, B1); PG8_BAR;
            }
        }
        if constexpr (ALIGN_EPI) { if (wr == 0) PG8_BAR; }
        if constexpr (!Epi::AFTER_DRAIN) { E(acc, cur, wr, wc, fr, fq); S.done(cur); }
        if (!has_next) break;
#pragma unroll
        for (int a = 0; a < 2; ++a)
#pragma unroll
            for (int b = 0; b < 2; ++b)
#pragma unroll
                for (int m = 0; m < 4; ++m)
#pragma unroll
                    for (int n = 0; n < 2; ++n) acc[a][b][m][n] = (f32x4){0.f, 0.f, 0.f, 0.f};
        cur = nxt; cA = nA; cB = nB; ++ui;
        if constexpr (ALIGN_EPI) { if (wr == 1) PG8_BAR; }
    }
    PG8_WAIT_V(0);
    if constexpr (!ALIGN_EPI) { if (wr == 0) PG8_BAR; }
    PG8_BAR;
    if constexpr (Epi::AFTER_DRAIN) { E.fused(acc, cur, wr, wc, fr, fq, lds, wid, lane); S.done(cur); }
#undef PG8_SA
#undef PG8_SB
#undef PG8_STAGE
#undef PG8_LDA
#undef PG8_LDB
#undef PG8_MMA
#undef PG8_WAIT_V
#undef PG8_WAIT_L
#undef PG8_BAR
#undef PG8_SCHED
}
}

namespace mla {
typedef short bf16x8 __attribute__((ext_vector_type(8)));
typedef short s16x4 __attribute__((ext_vector_type(4)));
typedef float f32x16 __attribute__((ext_vector_type(16)));
typedef unsigned u32x4 __attribute__((ext_vector_type(4)));
typedef unsigned u32x2 __attribute__((ext_vector_type(2)));
constexpr int KRS = 400, VRS = 320;
constexpr int KT_BYTES = 64 * KRS, VT_BYTES = 64 * VRS, BUF_BYTES = KT_BYTES + VT_BYTES;
__device__ __forceinline__ unsigned cvtpk(float lo, float hi) { typedef float f2 __attribute__((ext_vector_type(2))); typedef __bf16 b2 __attribute__((ext_vector_type(2))); f2 v = {lo, hi}; b2 b = __builtin_convertvector(v, b2); return __builtin_bit_cast(unsigned, b); }
__device__ __forceinline__ float half_max(float v) { auto rr = __builtin_amdgcn_permlane32_swap(__float_as_uint(v), __float_as_uint(v), false, false); return fmaxf(__uint_as_float(rr[0]), __uint_as_float(rr[1])); }
__device__ __forceinline__ float half_sum(float v) { auto rr = __builtin_amdgcn_permlane32_swap(__float_as_uint(v), __float_as_uint(v), false, false); return __uint_as_float(rr[0]) + __uint_as_float(rr[1]); }

__device__ __forceinline__ void attn_unit(LAS unsigned char* lds, const bf16_t* __restrict__ q, const bf16_t* __restrict__ kv, const bf16_t* __restrict__ kr, bf16_t* __restrict__ o, int b, int h, int qb, int tid) {
    const int lane = tid & 63, wave = __builtin_amdgcn_readfirstlane(tid >> 6), r32 = lane & 31, hi = lane >> 5;
    const size_t row0 = (size_t)b * S; const int q0 = qb * 256;
    const int NT = 4 * qb + 4, my_nt = 4 * qb + (wave >> 1) + 1;
    bf16x8 qf[12];
    { const bf16_t* qp = q + (row0 + q0 + wave * 32 + r32) * (MH * MQK) + h * MQK + 8 * hi;
#pragma unroll
      for (int ks = 0; ks < 12; ++ks) qf[ks] = *(const bf16x8*)(qp + 16 * ks); }
    const int srow = tid >> 4, sch = tid & 15, rrow = tid >> 3, rch = tid & 7;
    const bf16_t* gk = kv + (row0 + srow) * (MH * 256) + h * 256 + sch * 8;
    const bf16_t* gr = kr + (row0 + rrow) * 64 + rch * 8;
    const unsigned dk0 = srow * KRS + sch * 16, dr0 = rrow * KRS + 256 + rch * 16, dv0 = KT_BYTES + srow * VRS + sch * 16;
    u32x4 st[5];
#define MLA_ISSUE(t) do { const bf16_t* gk_ = gk + (size_t)(t) * 64 * (MH * 256); st[0] = *(const u32x4*)(gk_); st[1] = *(const u32x4*)(gk_ + (size_t)32 * (MH * 256)); \
        st[2] = *(const u32x4*)(gr + (size_t)(t) * 64 * 64); st[3] = *(const u32x4*)(gk_ + 128); st[4] = *(const u32x4*)(gk_ + (size_t)32 * (MH * 256) + 128); } while (0)
#define MLA_COMMIT(buf) do { LAS unsigned char* b_ = lds + (buf) * BUF_BYTES; *(LAS u32x4*)(b_ + dk0) = st[0]; *(LAS u32x4*)(b_ + dk0 + 32 * KRS) = st[1]; *(LAS u32x4*)(b_ + dr0) = st[2]; \
        *(LAS u32x4*)(b_ + dv0) = st[3]; *(LAS u32x4*)(b_ + dv0 + 32 * VRS) = st[4]; } while (0)
    const unsigned ka = r32 * KRS + hi * 16;
    const unsigned va = KT_BYTES + (4 * hi + ((lane & 15) >> 2)) * VRS + (16 * ((lane >> 4) & 1) + 4 * (lane & 3)) * 2;
    float m = -1e30f, l = 0.f;
    f32x16 O[4];
#pragma unroll
    for (int d = 0; d < 4; ++d)
#pragma unroll
        for (int r = 0; r < 16; ++r) O[d][r] = 0.f;
    const float c = 0.072168783648703220564f * 1.4426950408889634f;
    MLA_ISSUE(0); MLA_COMMIT(0); if (NT > 1) MLA_ISSUE(1);
    __syncthreads();
    for (int t = 0; t < NT; ++t) {
        const int buf = t & 1;
        if (t + 1 < NT) MLA_COMMIT(buf ^ 1);
        if (t + 2 < NT) MLA_ISSUE(t + 2);
        if (t < my_nt) {
            LAS unsigned char* kb = lds + buf * BUF_BYTES;
            f32x16 s0, s1;
#pragma unroll
            for (int r = 0; r < 16; ++r) { s0[r] = 0.f; s1[r] = 0.f; }
#pragma unroll
            for (int ks = 0; ks < 12; ++ks) {
                const bf16x8 a0 = *(const LAS bf16x8*)(kb + ka + ks * 32), a1 = *(const LAS bf16x8*)(kb + ka + 32 * KRS + ks * 32);
                s0 = __builtin_amdgcn_mfma_f32_32x32x16_bf16(a0, qf[ks], s0, 0, 0, 0);
                s1 = __builtin_amdgcn_mfma_f32_32x32x16_bf16(a1, qf[ks], s1, 0, 0, 0);
            }
            float mx = fmaxf(s0[0], s1[0]);
#pragma unroll
            for (int r = 1; r < 16; ++r) mx = fmaxf(mx, fmaxf(s0[r], s1[r]));
            mx = half_max(mx);
            const float mn = fmaxf(m, mx * c), alpha = __builtin_amdgcn_exp2f(m - mn); m = mn;
            float ps = 0.f;
#pragma unroll
            for (int r = 0; r < 16; ++r) { s0[r] = __builtin_amdgcn_exp2f(s0[r] * c - mn); s1[r] = __builtin_amdgcn_exp2f(s1[r] * c - mn); ps += s0[r] + s1[r]; }
            l = l * alpha + ps;
#pragma unroll
            for (int d = 0; d < 4; ++d)
#pragma unroll
                for (int r = 0; r < 16; ++r) O[d][r] *= alpha;
            u32x4 pf[4];
#pragma unroll
            for (int s = 0; s < 2; ++s) {
                pf[s] = (u32x4){cvtpk(s0[8 * s], s0[8 * s + 1]), cvtpk(s0[8 * s + 2], s0[8 * s + 3]), cvtpk(s0[8 * s + 4], s0[8 * s + 5]), cvtpk(s0[8 * s + 6], s0[8 * s + 7])};
                pf[2 + s] = (u32x4){cvtpk(s1[8 * s], s1[8 * s + 1]), cvtpk(s1[8 * s + 2], s1[8 * s + 3]), cvtpk(s1[8 * s + 4], s1[8 * s + 5]), cvtpk(s1[8 * s + 6], s1[8 * s + 7])};
            }
#pragma unroll
            for (int d = 0; d < 4; ++d)
#pragma unroll
                for (int f = 0; f < 4; ++f) {
                    const s16x4 lo = __builtin_bit_cast(s16x4, __builtin_amdgcn_ds_read_tr16_b64_v4i16((LAS s16x4*)(kb + va + (16 * f) * VRS + d * 64)));
                    const s16x4 hh = __builtin_bit_cast(s16x4, __builtin_amdgcn_ds_read_tr16_b64_v4i16((LAS s16x4*)(kb + va + (16 * f + 8) * VRS + d * 64)));
                    const bf16x8 vt = (bf16x8){lo[0], lo[1], lo[2], lo[3], hh[0], hh[1], hh[2], hh[3]};
                    O[d] = __builtin_amdgcn_mfma_f32_32x32x16_bf16(vt, __builtin_bit_cast(bf16x8, pf[f]), O[d], 0, 0, 0);
                }
        }
        __syncthreads();
    }
#undef MLA_ISSUE
#undef MLA_COMMIT
    l = half_sum(l);
    const float inv = 1.f / l;
    bf16_t* op = o + (row0 + q0 + wave * 32 + r32) * (MH * MV) + h * MV + 4 * hi;
#pragma unroll
    for (int d = 0; d < 4; ++d)
#pragma unroll
        for (int g = 0; g < 4; ++g) { u32x2 w; w.x = cvtpk(O[d][4 * g] * inv, O[d][4 * g + 1] * inv); w.y = cvtpk(O[d][4 * g + 2] * inv, O[d][4 * g + 3] * inv); *(u32x2*)(op + 32 * d + 8 * g) = w; }
}
__device__ __forceinline__ void attn_phase(LAS unsigned char* lds, const bf16_t* q, const bf16_t* kv, const bf16_t* kr, bf16_t* o, int bid, int nblk, int tid) {
    for (int u = bid; u < NB * MH * 4; u += nblk) {
        const int bh = u >> 2, s = u & 3;
        attn_unit(lds, q, kv, kr, o, bh / MH, bh % MH, s, tid);
        attn_unit(lds, q, kv, kr, o, bh / MH, bh % MH, 7 - s, tid);
    }
}
}

typedef float f32x4 __attribute__((ext_vector_type(4)));
typedef unsigned v4u __attribute__((ext_vector_type(4)));
typedef unsigned v2u __attribute__((ext_vector_type(2)));
constexpr int NWAVES = 8, NTHREADS = 512;
constexpr int LDS_BYTES = 147456;
constexpr size_t MiB = 1u << 20;
constexpr size_t WS_CTL = 0, WS_CS = 1 * MiB, WS_WSET0 = 5 * MiB, WS_WSET1 = 32 * MiB, WS_B0 = 59 * MiB, WS_B1 = 91 * MiB, WS_BIG = 123 * MiB, WS_AUX = 251 * MiB, WS_PP = 299 * MiB, WS_GLR = 331 * MiB, WS_END = 332 * MiB;
constexpr size_t WO_IN = 0, WO_UQ = 786432, WO_UKV = 1179648, WO_OUT = 3145728, WO_W1 = 4194304, WO_W2 = 8388608, WO_G = 12582912, WO_P = 13631488, WO_END = 13893632;
static_assert(WO_END * 2 <= 27 * MiB, "weight set fits its 27 MiB");

struct Args { const void* in[23]; float* out; unsigned char* ws; };

struct Ctx { int tid, lane, wave, gw, ngw, bid; LAS unsigned char* lds; };

__device__ __forceinline__ void tr_matrix(const Ctx& c, const float* W, int ldw, int K, int N, bf16_t* WT) {
    LAS float* scr = (LAS float*)(c.lds + c.wave * 16384);
    const int nblk = N / 32, nitems = (K / 64) * nblk, lane = c.lane;
    for (int it = c.gw; it < nitems; it += c.ngw) {
        const int kb = it / nblk, nb = it % nblk, k0 = 64 * kb, n0 = 32 * nb;
#pragma unroll 8
        for (int i = 0; i < 32; ++i) { const int kk = 2 * i + (lane >> 5); scr[kk * 33 + (lane & 31)] = W[(size_t)(k0 + kk) * ldw + n0 + (lane & 31)]; }
        asm volatile("s_waitcnt lgkmcnt(0)" ::: "memory");
        const int ch = lane & 7;
#pragma unroll
        for (int j = 0; j < 4; ++j) { const int n = (lane >> 3) + 8 * j; const LAS float* s = scr + (8 * ch) * 33 + n;
            v4u o; o.x = pk2(s[0 * 33], s[1 * 33]); o.y = pk2(s[2 * 33], s[3 * 33]); o.z = pk2(s[4 * 33], s[5 * 33]); o.w = pk2(s[6 * 33], s[7 * 33]);
            *(v4u*)(WT + (size_t)(n0 + n) * K + k0 + 8 * ch) = o; }
        asm volatile("s_waitcnt lgkmcnt(0)" ::: "memory");
    }
}
__device__ __forceinline__ void convert_weights(const Ctx& c, const Args& a, int i, bf16_t* WS) {
    const int j = i / 3, kind = i % 3;
    if (kind == 0) {
        tr_matrix(c, (const float*)a.in[3] + (size_t)j * D * GLA_IN, GLA_IN, D, 3072, WS + WO_IN);
        tr_matrix(c, (const float*)a.in[7] + (size_t)j * GHV * D, D, GHV, D, WS + WO_OUT);
    } else if (kind == 1) {
        tr_matrix(c, (const float*)a.in[8] + (size_t)j * D * MLA_IN, MLA_IN, D, MLA_IN, WS + WO_IN);
        { unsigned zz = 0u; asm volatile("" : "+v"(zz));
          for (size_t e = (size_t)c.bid * NTHREADS + c.tid; e < (size_t)(MLA_INP - MLA_IN) * D / 8; e += (size_t)gridDim.x * NTHREADS) *((v4u*)(WS + WO_IN + (size_t)MLA_IN * D) + e) = (v4u){zz, zz, zz, zz}; }
        tr_matrix(c, (const float*)a.in[11] + (size_t)j * 256 * 1536, 1536, 256, 1536, WS + WO_UQ);
        tr_matrix(c, (const float*)a.in[12] + (size_t)j * 256 * 2048, 2048, 256, 2048, WS + WO_UKV);
        tr_matrix(c, (const float*)a.in[13] + (size_t)j * D * D, D, D, D, WS + WO_OUT);
    } else {
        tr_matrix(c, (const float*)a.in[14] + (size_t)j * D * 3 * D, 3 * D, D, 3 * D, WS + WO_IN);
        tr_matrix(c, (const float*)a.in[16] + (size_t)j * D * D, D, D, D, WS + WO_OUT);
    }
    tr_matrix(c, (const float*)a.in[19] + (size_t)i * D * FF, FF, D, FF, WS + WO_W1);
    tr_matrix(c, (const float*)a.in[20] + (size_t)i * FF * D, D, FF, D, WS + WO_W2);
    tr_matrix(c, (const float*)a.in[21] + (size_t)i * D * D, D, D, D, WS + WO_G);
    tr_matrix(c, (const float*)a.in[22] + (size_t)i * PLE * D, D, PLE, D, WS + WO_P);
}
__device__ __forceinline__ void cvt_rows(const Ctx& c, const float* src, bf16_t* dst, size_t n) {
    for (size_t e = (size_t)c.bid * NTHREADS + c.tid; e < n / 4; e += (size_t)gridDim.x * NTHREADS) { const f32x4 v = ((const f32x4*)src)[e]; v2u o; o.x = pk2(v.x, v.y); o.y = pk2(v.z, v.w); ((v2u*)dst)[e] = o; }
}
__device__ __forceinline__ void ln_pass(const Ctx& c, float* X, const float* g, const float* b, bf16_t* xb) {
    for (int m = c.gw; m < M; m += c.ngw) {
        f32x4* xr = (f32x4*)(X + (size_t)m * D) + c.lane;
        f32x4 v[4]; float s = 0.f;
#pragma unroll
        for (int j = 0; j < 4; ++j) { v[j] = xr[64 * j]; s += (v[j].x + v[j].y) + (v[j].z + v[j].w); }
        const float mean = wave_sum(s) * (1.f / D); float s2 = 0.f;
#pragma unroll
        for (int j = 0; j < 4; ++j) { v[j] = v[j] - mean; s2 += (v[j].x * v[j].x + v[j].y * v[j].y) + (v[j].z * v[j].z + v[j].w * v[j].w); }
        const float rstd = 1.f / sqrtf(wave_sum(s2) * (1.f / D) + LN_EPS);
        v2u* o8 = (v2u*)(xb + (size_t)m * D) + c.lane;
#pragma unroll
        for (int j = 0; j < 4; ++j) { const f32x4 gg = ((const f32x4*)g)[c.lane + 64 * j], bb = ((const f32x4*)b)[c.lane + 64 * j]; const f32x4 o = v[j] * rstd * gg + bb;
            xr[64 * j] = o; v2u w; w.x = pk2(o.x, o.y); w.y = pk2(o.z, o.w); o8[64 * j] = w; }
    }
}


enum { T_NOP = 0, T_PROLOGUE, T_GEMM_BF16, T_GEMM_RELU2, T_GEMM_RES, T_GEMM_PLE, T_GLR, T_GLA_L, T_GLA_STATE, T_GLA_SCORES, T_GLA_OUTNORM, T_MLA_PREP, T_MLA_QROPE, T_MLA_ATTN, T_CONVMIX, T_LN, T_PCVT, T_WCVT };
struct Op { int type, sync, n0, n1; const void *a0, *a1, *a2, *a3, *a4; void *o0, *o1, *o2; };

__device__ __forceinline__ int n_mixer_steps(int kind) { return kind == 2 ? 2 : 6; }
__device__ __forceinline__ void decode(const Args& a, int i, int s, Op& op) {
    unsigned char* ws = a.ws;
    const int j = i / 3, kind = i % 3, nm = n_mixer_steps(kind);
    bf16_t* W = (bf16_t*)(ws + ((i & 1) ? WS_WSET1 : WS_WSET0));
    bf16_t* B0 = (bf16_t*)(ws + WS_B0); bf16_t* B1 = (bf16_t*)(ws + WS_B1); bf16_t* BIG = (bf16_t*)(ws + WS_BIG); bf16_t* AUX = (bf16_t*)(ws + WS_AUX); bf16_t* PP = (bf16_t*)(ws + WS_PP);
    float* XR = a.out; float* CS = (float*)(ws + WS_CS); float* GLR = (float*)(ws + WS_GLR);
    op.type = T_NOP; op.sync = 1; op.n0 = 0; op.n1 = 0; op.a0 = op.a1 = op.a2 = op.a3 = op.a4 = nullptr; op.o0 = op.o1 = op.o2 = nullptr;
    if (s < nm) {
        if (kind == 0) {
            bf16_t* PROJ = BIG; float* L = (float*)(ws + WS_BIG + 96 * MiB); bf16_t* ST = AUX; float* SC = (float*)(ws + WS_PP + 16 * MiB);
            switch (s) {
            case 0: op.type = T_GEMM_BF16; op.sync = 0; op.a0 = B0; op.a1 = W + WO_IN; op.n0 = 3072; op.n1 = D; op.o0 = PROJ; break;
            case 1: op.type = T_GLR; op.a0 = B0; op.a1 = (const float*)a.in[3] + (size_t)j * D * GLA_IN; op.o0 = GLR; break;
            case 2: op.type = T_GLA_L; op.a0 = GLR; op.a1 = (const float*)a.in[4] + (size_t)j * GRANK * GHK; op.a2 = (const float*)a.in[5] + (size_t)j * GHK; op.o0 = L; break;
            case 3: op.type = T_GLA_STATE; op.a0 = PROJ; op.a1 = L; op.o0 = ST; break;
            case 4: op.type = T_GLA_SCORES; op.a0 = PROJ; op.a1 = L; op.o0 = SC; break;
            default: op.type = T_GLA_OUTNORM; op.a0 = PROJ; op.a1 = L; op.a2 = SC; op.a3 = ST; op.a4 = (const float*)a.in[6] + (size_t)j * GDV; op.o0 = B1; break;
            }
        } else if (kind == 1) {
            bf16_t* Cb = AUX; bf16_t* cqn = AUX + (size_t)12 * MiB; bf16_t* ckvn = AUX + (size_t)16 * MiB; bf16_t* kr = AUX + (size_t)20 * MiB;
            bf16_t* q = BIG; bf16_t* kv = BIG + (size_t)24 * MiB;
            switch (s) {
            case 0: op.type = T_GEMM_BF16; op.a0 = B0; op.a1 = W + WO_IN; op.n0 = MLA_INP; op.n1 = D; op.o0 = Cb; break;
            case 1: op.type = T_MLA_PREP; op.a0 = Cb; op.a1 = (const float*)a.in[9] + j * 256; op.a2 = (const float*)a.in[10] + j * 256; op.a3 = CS; op.o0 = cqn; op.o1 = ckvn; op.o2 = kr; break;
            case 2: op.type = T_GEMM_BF16; op.sync = 0; op.a0 = cqn; op.a1 = W + WO_UQ; op.n0 = 1536; op.n1 = 256; op.o0 = q; break;
            case 3: op.type = T_GEMM_BF16; op.a0 = ckvn; op.a1 = W + WO_UKV; op.n0 = 2048; op.n1 = 256; op.o0 = kv; break;
            case 4: op.type = T_MLA_QROPE; op.a0 = CS; op.o0 = q; break;
            default: op.type = T_MLA_ATTN; op.a0 = q; op.a1 = kv; op.a2 = kr; op.o0 = B1; break;
            }
        } else {
            if (s == 0) { op.type = T_GEMM_BF16; op.a0 = B0; op.a1 = W + WO_IN; op.n0 = 3 * D; op.n1 = D; op.o0 = BIG; }
            else { op.type = T_CONVMIX; op.a0 = BIG; op.a1 = (const float*)a.in[15] + (size_t)j * 3 * D; op.o0 = B1; }
        }
    } else {
        switch (s - nm) {
        case 0: op.type = T_GEMM_RES; op.a0 = B1; op.a1 = W + WO_OUT; op.n0 = D; op.n1 = D; op.a2 = (i == 0) ? (const float*)a.in[0] : XR; op.o0 = XR; break;
        case 1: op.type = T_LN; op.sync = 0; op.a0 = (const float*)a.in[17] + (size_t)(2 * i) * D; op.a1 = (const float*)a.in[18] + (size_t)(2 * i) * D; op.o0 = XR; op.o1 = B0; break;
        case 2: op.type = T_PCVT; op.sync = 0; op.a0 = (const float*)a.in[1] + (size_t)i * M * PLE; op.o0 = AUX; break;
        case 3: op.type = (i + 1 < DEPTH) ? T_WCVT : T_NOP; op.n0 = i + 1; op.o0 = ws + (((i + 1) & 1) ? WS_WSET1 : WS_WSET0); break;
        case 4: op.type = T_GEMM_RELU2; op.sync = 0; op.a0 = B0; op.a1 = W + WO_W1; op.n0 = FF; op.n1 = D; op.o0 = BIG; break;
        case 5: op.type = T_GEMM_BF16; op.a0 = AUX; op.a1 = W + WO_P; op.n0 = D; op.n1 = PLE; op.o0 = PP; break;
        case 6: op.type = T_GEMM_RES; op.a0 = BIG; op.a1 = W + WO_W2; op.n0 = D; op.n1 = FF; op.a2 = XR; op.o0 = XR; break;
        case 7: op.type = T_LN; op.a0 = (const float*)a.in[17] + (size_t)(2 * i + 1) * D; op.a1 = (const float*)a.in[18] + (size_t)(2 * i + 1) * D; op.o0 = XR; op.o1 = B1; break;
        default: op.type = T_GEMM_PLE; op.sync = (i + 1 < DEPTH) ? 1 : 0; op.a0 = B1; op.a1 = W + WO_G; op.n0 = D; op.n1 = D; op.a2 = PP; op.o0 = XR; op.o1 = B0; break;
        }
    }
}

#define RUN_GEMM(EPI_T, ...) do { pg8::Gemm g_{(const bf16_t*)op.a0, (const bf16_t*)op.a1, M, op.n0, op.n1}; pg8::StaticOrder S_; S_.init(M, op.n0, (int)gridDim.x, c.bid); \
    EPI_T E_{__VA_ARGS__}; pg8::gemm_phase<EPI_T, pg8::StaticOrder, true, true>(c.lds, g_, S_, E_); } while (0)

__global__ void __launch_bounds__(NTHREADS, 2) mega_fwd(Args a) {
    extern __shared__ __attribute__((aligned(16))) unsigned char lds_raw[];
    cg::grid_group grid = cg::this_grid();
    for (int i = -1; i < DEPTH; ++i) {
        const int ns = (i < 0) ? 1 : n_mixer_steps(i % 3) + 9;
        for (int s = 0; s < ns; ++s) {
            Ctx c; c.tid = tid_now(); c.bid = bid_now(); c.lane = c.tid & 63; c.wave = __builtin_amdgcn_readfirstlane(c.tid >> 6); c.gw = c.bid * NWAVES + c.wave; c.ngw = gridDim.x * NWAVES; c.lds = (LAS unsigned char*)lds_raw;
            Op op;
            if (i < 0) { op.type = T_PROLOGUE; op.sync = 1; op.n0 = op.n1 = 0; op.a0 = op.a1 = op.a2 = op.a3 = op.a4 = nullptr; op.o0 = op.o1 = op.o2 = nullptr; }
            else decode(a, i, s, op);
            switch (op.type) {
            case T_PROLOGUE: {
                const int* pos = (const int*)a.in[2]; float* CS = (float*)(a.ws + WS_CS);
                for (size_t e = (size_t)c.bid * NTHREADS + c.tid; e < (size_t)M * 32; e += (size_t)gridDim.x * NTHREADS) {
                    const int jj = (int)(e & 31); const size_t m = e >> 5; const float ang = (float)pos[m] * inv_freq(jj);
                    float sn_, cs_; sincosf(ang, &sn_, &cs_); CS[m * 64 + jj] = cs_; CS[m * 64 + 32 + jj] = sn_;
                }
                cvt_rows(c, (const float*)a.in[0], (bf16_t*)(a.ws + WS_B0), (size_t)M * D);
                convert_weights(c, a, 0, (bf16_t*)(a.ws + WS_WSET0));
            } break;
            case T_GEMM_BF16: RUN_GEMM(pg8::EpiBf16<0>, (bf16_t*)op.o0, op.n0); break;
            case T_GEMM_RELU2: RUN_GEMM(pg8::EpiBf16<2>, (bf16_t*)op.o0, op.n0); break;
            case T_GEMM_RES: RUN_GEMM(pg8::EpiRes, (const float*)op.a2, (float*)op.o0, D, ALPHA); break;
            case T_GEMM_PLE: RUN_GEMM(pg8::EpiPle, (const float*)op.o0, (float*)op.o0, (const bf16_t*)op.a2, (bf16_t*)op.o1, D); break;
            case T_GLR: gla_glr<bf16_t>((const bf16_t*)op.a0, (const float*)op.a1, (float*)op.o0, M); break;
            case T_GLA_L: gla_L<float>((const float*)op.a0, GRANK, (const float*)op.a1, (const float*)op.a2, (float*)op.o0, M); break;
            case T_GLA_STATE: gla_state<bf16_t, bf16_t>((const bf16_t*)op.a0 + 512, 3072, (const bf16_t*)op.a0 + 1024, 3072, (const float*)op.a1, (bf16_t*)op.o0, NB); break;
            case T_GLA_SCORES: gla_scores<bf16_t>((const bf16_t*)op.a0, 3072, (const bf16_t*)op.a0 + 512, 3072, (const float*)op.a1, (float*)op.o0, NB); break;
            case T_GLA_OUTNORM: gla_out_norm<bf16_t, bf16_t, bf16_t>((const bf16_t*)op.a0, 3072, (const bf16_t*)op.a0 + 1024, 3072, (const bf16_t*)op.a0 + 2048, 3072, (const float*)op.a1, (const float*)op.a2, (const bf16_t*)op.a3, (const float*)op.a4, (bf16_t*)op.o0, M); break;
            case T_MLA_PREP: mla_prep<bf16_t, bf16_t>((const bf16_t*)op.a0, MLA_INP, (const float*)op.a1, (const float*)op.a2, (const float*)op.a3, (bf16_t*)op.o0, (bf16_t*)op.o1, (bf16_t*)op.o2, M); break;
            case T_MLA_QROPE: mla_qrope<bf16_t>((bf16_t*)op.o0, (const float*)op.a0, M); break;
            case T_MLA_ATTN: mla::attn_phase(c.lds, (const bf16_t*)op.a0, (const bf16_t*)op.a1, (const bf16_t*)op.a2, (bf16_t*)op.o0, c.bid, (int)gridDim.x, c.tid); break;
            case T_CONVMIX: conv_mix<bf16_t, bf16_t>((const bf16_t*)op.a0, 3 * D, (const float*)op.a1, (bf16_t*)op.o0, M); break;
            case T_LN: ln_pass(c, (float*)op.o0, (const float*)op.a0, (const float*)op.a1, (bf16_t*)op.o1); break;
            case T_PCVT: cvt_rows(c, (const float*)op.a0, (bf16_t*)op.o0, (size_t)M * PLE); break;
            case T_WCVT: convert_weights(c, a, op.n0, (bf16_t*)op.o0); break;
            default: break;
            }
            if (op.sync) grid.sync();
        }
    }
}

extern "C" void kernel_launch(void* const* d_in, const int* in_sizes, int n_in, void* d_out, int out_size, void* d_ws, size_t ws_size, hipStream_t stream) {
    static int grid = 0;
    if (grid == 0) {
        if (n_in != 23 || out_size != M * D || ws_size < WS_END) { fprintf(stderr, "kernel_launch: unexpected shapes/workspace (n_in %d out %d ws %zu need %zu)\n", n_in, out_size, ws_size, (size_t)WS_END); grid = -1; return; }
        int dev = 0, cus = 0, per_cu = 0;
        (void)hipGetDevice(&dev); (void)hipDeviceGetAttribute(&cus, hipDeviceAttributeMultiprocessorCount, dev);
        if (hipFuncSetAttribute((const void*)mega_fwd, hipFuncAttributeMaxDynamicSharedMemorySize, LDS_BYTES) != hipSuccess) { fprintf(stderr, "kernel_launch: hipFuncSetAttribute failed\n"); grid = -1; return; }
        (void)hipOccupancyMaxActiveBlocksPerMultiprocessor(&per_cu, (const void*)mega_fwd, NTHREADS, LDS_BYTES);
        if (per_cu < 1) { fprintf(stderr, "kernel_launch: occupancy query says %d blocks per CU\n", per_cu); grid = -1; return; }
        grid = cus;
    }
    if (grid < 0) return;
    Args a{};
    for (int i = 0; i < 23; ++i) a.in[i] = d_in[i];
    a.out = (float*)d_out; a.ws = (unsigned char*)d_ws;
    void* args[] = {&a};
    hipError_t e = hipLaunchCooperativeKernel((const void*)mega_fwd, dim3(grid), dim3(NTHREADS), args, LDS_BYTES, stream);
    if (e != hipSuccess) fprintf(stderr, "cooperative launch failed: %s (grid %d)\n", hipGetErrorString(e), grid);
}
```

```cpp
#include <hip/hip_runtime.h>
#include <hip/hip_cooperative_groups.h>
#include <cstdint>
#include <cstdio>
namespace cg = cooperative_groups;

constexpr int NB = 8, S = 2048, D = 1024, M = NB * S, DEPTH = 4, CH = 64, NCH = S / CH;
constexpr int FF = 4096, PLE = 256;
constexpr int GLA_IN = 3088, GH = 4, GDK = 128, GDV = 256, GHK = 512, GHV = 1024, GRANK = 16;
constexpr int MLA_IN = 576, MLA_INP = 768, MH = 8, MNOPE = 128, MROPE = 64, MV = 128, MQK = 192;
constexpr float ALPHA = 1.6817928305074290860622509524664f;
constexpr float LN_EPS = 1e-5f, RMS_EPS = 1e-6f;

#define LAS __attribute__((address_space(3)))
typedef unsigned short bf16_t;
__device__ __forceinline__ float ldf(const float* p, size_t i) { return p[i]; }
__device__ __forceinline__ float ldf(const bf16_t* p, size_t i) { return __uint_as_float(((unsigned)p[i]) << 16); }
__device__ __forceinline__ unsigned f2bf(float f) { unsigned u = __float_as_uint(f); return (u + 0x7fffu + ((u >> 16) & 1u)) >> 16; }
__device__ __forceinline__ unsigned pk2(float lo, float hi) { return f2bf(lo) | (f2bf(hi) << 16); }
__device__ __forceinline__ float bflo(unsigned w) { return __uint_as_float(w << 16); }
__device__ __forceinline__ float bfhi(unsigned w) { return __uint_as_float(w & 0xffff0000u); }
__device__ __forceinline__ void stf(float* p, size_t i, float v) { p[i] = v; }
__device__ __forceinline__ void stf(bf16_t* p, size_t i, float v) { p[i] = (bf16_t)f2bf(v); }
__device__ __forceinline__ float wave_sum(float v) {
#pragma unroll
    for (int o = 1; o < 64; o <<= 1) v += __shfl_xor(v, o);
    return v;
}
__device__ __forceinline__ float wave_max(float v) {
#pragma unroll
    for (int o = 1; o < 64; o <<= 1) v = fmaxf(v, __shfl_xor(v, o));
    return v;
}
__device__ __forceinline__ float log_sigmoid(float z) { return fminf(z, 0.f) - log1pf(expf(-fabsf(z))); }
__device__ __forceinline__ float sigmoidf_(float z) { return 1.f / (1.f + expf(-z)); }
__device__ const float INV_FREQ[32] = {1.0f, 0.7498942017555237f, 0.5623413324356079f, 0.4216965138912201f, 0.3162277638912201f, 0.23713737726211548f, 0.17782793939113617f, 0.1333521455526352f, 0.10000000149011612f, 0.0749894231557846f, 0.05623413249850273f, 0.04216964915394783f, 0.03162277489900589f, 0.023713737726211548f, 0.017782794311642647f, 0.013335213996469975f, 0.009999999776482582f, 0.007498942315578461f, 0.005623413249850273f, 0.0042169648222625256f, 0.003162277629598975f, 0.0023713738191872835f, 0.0017782794311642647f, 0.0013335214462131262f, 0.0010000000474974513f, 0.0007498941849917173f, 0.000562341301701963f, 0.0004216965171508491f, 0.0003162277571391314f, 0.00023713737027719617f, 0.00017782794020604342f, 0.0001333521504420787f};
__device__ __forceinline__ float inv_freq(int j) { return INV_FREQ[j]; }

constexpr int NTHR = 512;
__device__ __forceinline__ int tid_now() { int t = threadIdx.x; asm volatile("" : "+v"(t)); return t; }
__device__ __forceinline__ int bid_now() { int b = blockIdx.x; asm volatile("" : "+s"(b)); return b; }
__device__ __forceinline__ int nblk_now() { int g = gridDim.x; asm volatile("" : "+s"(g)); return g; }
#define GSTRIDE(i, n) for (size_t i = (size_t)bid_now() * NTHR + tid_now(), _st = (size_t)nblk_now() * NTHR; i < (size_t)(n); i += _st)
#define WSTRIDE_DECL const int _t = tid_now(); const int lane = _t & 63; const size_t gw = ((size_t)bid_now() * NTHR + _t) >> 6, nw = ((size_t)nblk_now() * NTHR) >> 6

template <class T> __device__ __forceinline__ void gla_glr(const T* xb, const float* Win, float* glr, int Mloc) {
    WSTRIDE_DECL;
    for (size_t m = gw; m < (size_t)Mloc; m += nw) {
        float acc[GRANK];
#pragma unroll
        for (int r = 0; r < GRANK; ++r) acc[r] = 0.f;
        for (int i = 0; i < D / 64; ++i) { const int k = lane + 64 * i; const float xv = ldf(xb, m * D + k); const float* w = Win + (size_t)k * GLA_IN + 3072;
#pragma unroll
            for (int r = 0; r < GRANK; ++r) acc[r] += xv * w[r]; }
#pragma unroll
        for (int r = 0; r < GRANK; ++r) { const float s = wave_sum(acc[r]); if (lane == r) glr[m * GRANK + r] = s; }
    }
}
template <class T> __device__ __forceinline__ void gla_L(const T* glr, int ldg, const float* wgu, const float* bg, float* L, int Mloc) {
    GSTRIDE(idx, (size_t)(Mloc / CH) * GHK) {
        const int ch = (int)(idx % GHK); const int cn = (int)(idx / GHK);
        float acc = 0.f;
        for (int t = 0; t < CH; ++t) {
            const size_t m = (size_t)cn * CH + t; float z = bg[ch];
            for (int r = 0; r < GRANK; ++r) z += ldf(glr, m * ldg + r) * wgu[r * GHK + ch];
            acc += log_sigmoid(z) * (1.f / 16.f);
            L[m * GHK + ch] = acc;
        }
    }
}
template <class T, class TO> __device__ __forceinline__ void gla_state(const T* k, int ldk, const T* v, int ldv, const float* L, TO* ST, int nb) {
    GSTRIDE(idx, (size_t)nb * GH * GDK * GDV) {
        const int dv = (int)(idx % GDV), dk = (int)((idx / GDV) % GDK), h = (int)((idx / (GDV * GDK)) % GH), b = (int)(idx / ((size_t)GDV * GDK * GH));
        float st = 0.f;
        for (int n = 0; n < NCH; ++n) {
            stf(ST, (((size_t)(b * GH + h) * NCH + n) * GDK + dk) * GDV + dv, st);
            const size_t m0 = (size_t)b * S + n * CH;
            const float Lend = L[(m0 + CH - 1) * GHK + h * GDK + dk];
            float acc = 0.f;
            for (int s = 0; s < CH; ++s) { const size_t m = m0 + s; acc += ldf(k, m * ldk + h * GDK + dk) * expf(Lend - L[m * GHK + h * GDK + dk]) * ldf(v, m * ldv + h * GDV + dv); }
            st = expf(Lend) * st + acc;
        }
    }
}
template <class T> __device__ __forceinline__ void gla_scores(const T* q, int ldq, const T* k, int ldk, const float* L, float* SC, int nb) {
    GSTRIDE(idx, (size_t)nb * GH * NCH * CH * CH) {
        const int s = (int)(idx % CH), t = (int)((idx / CH) % CH); const size_t unit = idx / (CH * CH);
        const int n = (int)(unit % NCH), h = (int)((unit / NCH) % GH), b = (int)(unit / (NCH * GH));
        const size_t mt = (size_t)b * S + n * CH + t, ms = (size_t)b * S + n * CH + s;
        float acc = 0.f;
        for (int d = 0; d < GDK; ++d) acc += ldf(q, mt * ldq + h * GDK + d) * ldf(k, ms * ldk + h * GDK + d) * expf(-fabsf(L[mt * GHK + h * GDK + d] - L[ms * GHK + h * GDK + d]));
        SC[idx] = acc * 0.088388347648318440550f;
    }
}
template <class T, class TS, class TO> __device__ __forceinline__ void gla_out_norm(const T* q, int ldq, const T* v, int ldv, const T* r, int ldr, const float* L, const float* SC, const TS* ST, const float* g, TO* OG, int Mloc) {
    WSTRIDE_DECL;
    for (size_t it = gw; it < (size_t)Mloc * GH; it += nw) {
        const size_t m = it / GH; const int h = (int)(it % GH);
        const int b = (int)(m / S), tt = (int)(m % S), n = tt / CH, t = tt % CH;
        const size_t unit = (size_t)(b * GH + h) * NCH + n, m0 = (size_t)b * S + n * CH;
        float o[4] = {0.f, 0.f, 0.f, 0.f};
        for (int s = 0; s < CH; ++s) { const float sc = SC[(unit * CH + t) * CH + s];
#pragma unroll
            for (int j = 0; j < 4; ++j) o[j] += sc * ldf(v, (m0 + s) * ldv + h * GDV + lane + 64 * j); }
        float o2[4] = {0.f, 0.f, 0.f, 0.f};
        for (int dk = 0; dk < GDK; ++dk) { const float qe = ldf(q, m * ldq + h * GDK + dk) * expf(L[m * GHK + h * GDK + dk]);
#pragma unroll
            for (int j = 0; j < 4; ++j) o2[j] += qe * ldf(ST, (unit * GDK + dk) * GDV + lane + 64 * j); }
        float ss = 0.f;
#pragma unroll
        for (int j = 0; j < 4; ++j) { o[j] += o2[j] * 0.088388347648318440550f; ss += o[j] * o[j]; }
        const float rstd = rsqrtf(wave_sum(ss) * (1.f / GDV) + RMS_EPS);
#pragma unroll
        for (int j = 0; j < 4; ++j) { const int dv = lane + 64 * j; const float rv = ldf(r, m * ldr + h * GDV + dv); stf(OG, m * GHV + h * GDV + dv, o[j] * rstd * g[dv] * (rv * sigmoidf_(rv))); }
    }
}
template <class T, class TO> __device__ __forceinline__ void mla_prep(const T* Cb, int ldc, const float* qn, const float* kvn, const float* cs, TO* cqn, TO* ckvn, TO* kr, int Mloc) {
    WSTRIDE_DECL;
    for (size_t m = gw; m < (size_t)Mloc; m += nw) {
        float a[4], c[4], sa = 0.f, sc = 0.f;
#pragma unroll
        for (int j = 0; j < 4; ++j) { a[j] = ldf(Cb, m * ldc + lane + 64 * j); c[j] = ldf(Cb, m * ldc + 256 + lane + 64 * j); sa += a[j] * a[j]; sc += c[j] * c[j]; }
        const float ra = rsqrtf(wave_sum(sa) * (1.f / 256.f) + RMS_EPS), rc = rsqrtf(wave_sum(sc) * (1.f / 256.f) + RMS_EPS);
#pragma unroll
        for (int j = 0; j < 4; ++j) { const int d = lane + 64 * j; stf(cqn, m * 256 + d, a[j] * ra * qn[d]); stf(ckvn, m * 256 + d, c[j] * rc * kvn[d]); }
        if (lane < 32) {
            const float x1 = ldf(Cb, m * ldc + 512 + lane), x2 = ldf(Cb, m * ldc + 544 + lane);
            const float csn = cs[m * 64 + lane], sn = cs[m * 64 + 32 + lane];
            stf(kr, m * 64 + lane, x1 * csn - x2 * sn); stf(kr, m * 64 + 32 + lane, x2 * csn + x1 * sn);
        }
    }
}
template <class T> __device__ __forceinline__ void mla_qrope(T* q, const float* cs, int Mloc) {
    GSTRIDE(idx, (size_t)Mloc * MH * 32) {
        const int j = (int)(idx % 32), h = (int)((idx / 32) % MH); const size_t m = idx / (32 * MH);
        const size_t o = m * (MH * MQK) + h * MQK + MNOPE + j;
        const float x1 = ldf(q, o), x2 = ldf(q, o + 32);
        const float csn = cs[m * 64 + j], sn = cs[m * 64 + 32 + j];
        stf(q, o, x1 * csn - x2 * sn); stf(q, o + 32, x2 * csn + x1 * sn);
    }
}
template <class T, class TO> __device__ __forceinline__ void mla_attn(const T* q, const T* kv, const T* kr, TO* o, int nb, float* sc) {
    WSTRIDE_DECL;
    for (size_t it = gw; it < (size_t)nb * MH * S; it += nw) {
        const int qi = (int)(it % S), h = (int)((it / S) % MH), b = (int)(it / ((size_t)S * MH));
        const size_t m = (size_t)b * S + qi; const int lim = (qi / CH + 1) * CH;
        const T* qp = q + m * (MH * MQK) + h * MQK;
        float mx = -INFINITY;
        for (int s = lane; s < lim; s += 64) {
            const size_t ms = (size_t)b * S + s; const T* kp = kv + ms * (MH * 256) + h * 256; const T* rp = kr + ms * 64;
            float dot = 0.f;
            for (int d = 0; d < MNOPE; ++d) dot += ldf(qp, d) * ldf(kp, d);
            for (int j = 0; j < MROPE; ++j) dot += ldf(qp, MNOPE + j) * ldf(rp, j);
            dot *= 0.072168783648703220564f;
            sc[s] = dot; mx = fmaxf(mx, dot);
        }
        mx = wave_max(mx);
        float sum = 0.f;
        for (int s = lane; s < lim; s += 64) { const float p = expf(sc[s] - mx); sc[s] = p; sum += p; }
        sum = wave_sum(sum);
        __builtin_amdgcn_s_waitcnt(0); __builtin_amdgcn_wave_barrier();
        float a0 = 0.f, a1 = 0.f;
        for (int s = 0; s < lim; ++s) { const size_t ms = (size_t)b * S + s; const float p = sc[s]; a0 += p * ldf(kv, ms * (MH * 256) + h * 256 + 128 + lane); a1 += p * ldf(kv, ms * (MH * 256) + h * 256 + 192 + lane); }
        const float inv = 1.f / sum;
        stf(o, m * (MH * MV) + h * MV + lane, a0 * inv); stf(o, m * (MH * MV) + h * MV + 64 + lane, a1 * inv);
        __builtin_amdgcn_s_waitcnt(0); __builtin_amdgcn_wave_barrier();
    }
}
template <class T, class TO> __device__ __forceinline__ void conv_mix(const T* bcu, int ld, const float* cw, TO* a, int Mloc) {
    GSTRIDE(idx, (size_t)Mloc * D) {
        const int c = (int)(idx % D); const size_t m = idx / D; const int t = (int)(m % S);
        float z = 0.f;
#pragma unroll
        for (int j = 0; j < 3; ++j) { const int dt = 2 - j; if (t - dt >= 0) { const size_t mm = m - dt; z += cw[j * D + c] * ldf(bcu, mm * ld + D + c) * ldf(bcu, mm * ld + 2 * D + c); } }
        stf(a, idx, ldf(bcu, m * ld + c) * z);
    }
}

template <class T, class TO> __device__ __forceinline__ void gla_state2(const T* proj, const float* DEC, TO* ST, int nb) {
    GSTRIDE(idx, (size_t)nb * GH * GDK * GDV) {
        const int dk = (int)(idx % GDK), dv = (int)((idx / GDK) % GDV), h = (int)((idx / (GDV * GDK)) % GH), b = (int)(idx / ((size_t)GDV * GDK * GH));
        float st = 0.f;
        for (int n = 0; n < NCH; ++n) {
            stf(ST, (((size_t)(b * GH + h) * NCH + n) * GDV + dv) * GDK + dk, st);
            const size_t m0 = (size_t)b * S + n * CH; float acc = 0.f;
            for (int s = 0; s < CH; ++s) { const size_t m = m0 + s; acc += ldf(proj, m * 4096 + 1536 + h * GDK + dk) * ldf(proj, m * 4096 + 2048 + h * GDV + dv); }
            st = DEC[((size_t)b * NCH + n) * GHK + h * GDK + dk] * (st + acc);
        }
    }
}
namespace pg8 {
#define PG8_LAS __attribute__((address_space(3)))
typedef unsigned short bf16_t;
typedef short bf16x8 __attribute__((ext_vector_type(8)));
typedef float f32x4 __attribute__((ext_vector_type(4)));
typedef unsigned u32x4 __attribute__((ext_vector_type(4)));
constexpr int BM = 256, BK = 64, HALF = 128, HTB = HALF * BK * 2  , STAGE_BYTES = 8 * HTB, NXCD = 8, WGM = 8;

__host__ __device__ __forceinline__ int lds_byte(int r, int c) { const int st = (r >> 4) * 2 + (c >> 5), rr = r & 15, cc = c & 31, ob = rr * 64 + cc * 2; return st * 1024 + (ob ^ (((ob >> 9) & 1) << 5)); }
__host__ __device__ __forceinline__ void stage_rc(int b, int& R, int& C) { const int st = b / 1024, sb = b % 1024, swz = sb ^ (((sb >> 9) & 1) << 5); R = (st >> 1) * 16 + swz / 64; C = (st & 1) * 32 + (swz % 64) / 2; }
__host__ __device__ __forceinline__ int perm32(int rho) { const int n = rho >> 4, i = rho & 15; return 8 * (i >> 2) + 4 * n + (i & 3); }

struct Unit { int pm, pn; };
struct Gemm { const bf16_t* A; const bf16_t* Bt; int M, N, K; };

struct StaticOrder {
    int nM, nN, nwg, G, c;
    __host__ __device__ void init(int M, int N, int G_, int c_) { nM = M / BM; nN = N / BM; nwg = nM * nN; G = G_; c = c_; }
    __host__ __device__ bool next(int i, Unit& u) const {
        const long L = (long)i * G + c; if (L >= nwg) return false;
        int wgid = (int)L; { const int q = nwg / NXCD, r = nwg % NXCD, xcd = wgid % NXCD, off = wgid / NXCD; wgid = (xcd < r ? xcd * (q + 1) : r * (q + 1) + (xcd - r) * q) + off; }
        const int nig = WGM * nN, gid = wgid / nig, fm = gid * WGM, gsz = (nM - fm) < WGM ? (nM - fm) : WGM;
        u.pm = fm + ((wgid % nig) % gsz); u.pn = (wgid % nig) / gsz; return true;
    }
    __device__ __forceinline__ void a_ready(const Unit&) const {}
    __device__ __forceinline__ void done(const Unit&) const {}
};


__device__ __forceinline__ unsigned cvt_pk_bf16(float lo, float hi) { unsigned r; asm volatile("v_cvt_pk_bf16_f32 %0, %1, %2" : "=v"(r) : "v"(lo), "v"(hi)); return r; }
typedef unsigned u32x2 __attribute__((ext_vector_type(2)));
template <int ACT  > struct EpiBf16 {
    static constexpr bool PERM = true, AFTER_DRAIN = false;
    bf16_t* O; int ldc;
    __device__ __forceinline__ void operator()(const f32x4 (&acc)[2][2][4][2], const Unit& u, int wr, int wc, int fr, int fq) const {
        const int row0 = u.pm * BM + wr * 64 + fr, col0 = u.pn * BM + wc * 32 + 8 * fq;
#pragma unroll
        for (int ai = 0; ai < 2; ++ai)
#pragma unroll
            for (int m = 0; m < 4; ++m) { bf16_t* rowp = O + (size_t)(row0 + ai * HALF + m * 16) * ldc + col0;
#pragma unroll
                for (int bj = 0; bj < 2; ++bj) { f32x4 v0 = acc[ai][bj][m][0], v1 = acc[ai][bj][m][1];
                    if (ACT == 2) {
#pragma unroll
                        for (int e = 0; e < 4; ++e) { float a = fmaxf(v0[e], 0.f); v0[e] = a * a; float b = fmaxf(v1[e], 0.f); v1[e] = b * b; } }
                    u32x4 w; w.x = cvt_pk_bf16(v0[0], v0[1]); w.y = cvt_pk_bf16(v0[2], v0[3]); w.z = cvt_pk_bf16(v1[0], v1[1]); w.w = cvt_pk_bf16(v1[2], v1[3]);
                    *(u32x4*)(rowp + bj * HALF) = w; } }
    }
};
struct EpiRes {
    static constexpr bool PERM = false, AFTER_DRAIN = false;
    const float* base; float* out; int ldc; float alpha;
    __device__ __forceinline__ void operator()(const f32x4 (&acc)[2][2][4][2], const Unit& u, int wr, int wc, int fr, int fq) const {
        const int col0 = u.pn * BM + wc * 32 + 4 * fq;
#pragma unroll
        for (int ai = 0; ai < 2; ++ai)
#pragma unroll
            for (int m = 0; m < 4; ++m) { const size_t off = (size_t)(u.pm * BM + ai * HALF + wr * 64 + m * 16 + fr) * ldc + col0;
#pragma unroll
                for (int bj = 0; bj < 2; ++bj)
#pragma unroll
                    for (int n = 0; n < 2; ++n) { const f32x4 bs = *(const f32x4*)(base + off + bj * HALF + n * 16); *(f32x4*)(out + off + bj * HALF + n * 16) = bs * alpha + acc[ai][bj][m][n]; } }
    }
};
struct EpiPle {
    static constexpr bool PERM = false, AFTER_DRAIN = false;
    const float* xin; float* xout; const bf16_t* P; bf16_t* xb; int ldc;
    __device__ __forceinline__ void operator()(const f32x4 (&acc)[2][2][4][2], const Unit& u, int wr, int wc, int fr, int fq) const {
        const int col0 = u.pn * BM + wc * 32 + 4 * fq;
#pragma unroll
        for (int ai = 0; ai < 2; ++ai)
#pragma unroll
            for (int m = 0; m < 4; ++m) { const size_t off = (size_t)(u.pm * BM + ai * HALF + wr * 64 + m * 16 + fr) * ldc + col0;
#pragma unroll
                for (int bj = 0; bj < 2; ++bj)
#pragma unroll
                    for (int n = 0; n < 2; ++n) { const size_t o = off + bj * HALF + n * 16; const f32x4 x2 = *(const f32x4*)(xin + o); const u32x2 pw = *(const u32x2*)(P + o); const f32x4 a = acc[ai][bj][m][n];
                        f32x4 r; r[0] = x2[0] + __uint_as_float(pw.x << 16) / (1.f + __expf(-a[0])); r[1] = x2[1] + __uint_as_float(pw.x & 0xffff0000u) / (1.f + __expf(-a[1]));
                        r[2] = x2[2] + __uint_as_float(pw.y << 16) / (1.f + __expf(-a[2])); r[3] = x2[3] + __uint_as_float(pw.y & 0xffff0000u) / (1.f + __expf(-a[3]));
                        *(f32x4*)(xout + o) = r; u32x2 w; w.x = cvt_pk_bf16(r[0], r[1]); w.y = cvt_pk_bf16(r[2], r[3]); *(u32x2*)(xb + o) = w; } }
    }
};

struct EpiGla {
    static constexpr bool PERM = true, AFTER_DRAIN = false;
    bf16_t* O; const float* L;
    __device__ __forceinline__ void operator()(const f32x4 (&acc)[2][2][4][2], const Unit& u, int wr, int wc, int fr, int fq) const {
        const int row0 = u.pm * BM + wr * 64 + fr, cl = wc * 32 + 8 * fq;
        if (u.pn >= 4) {
#pragma unroll
            for (int ai = 0; ai < 2; ++ai)
#pragma unroll
                for (int m = 0; m < 4; ++m) { bf16_t* rowp = O + (size_t)(row0 + ai * HALF + m * 16) * 4096 + 1024 + u.pn * BM + cl;
#pragma unroll
                    for (int bj = 0; bj < 2; ++bj) { const f32x4 v0 = acc[ai][bj][m][0], v1 = acc[ai][bj][m][1];
                        u32x4 w; w.x = cvt_pk_bf16(v0[0], v0[1]); w.y = cvt_pk_bf16(v0[2], v0[3]); w.z = cvt_pk_bf16(v1[0], v1[1]); w.w = cvt_pk_bf16(v1[2], v1[3]);
                        *(u32x4*)(rowp + bj * HALF) = w; } }
        } else {
            const bool isq = u.pn < 2; const float sc = isq ? 0.088388347648318440550f : 1.f;
            const int ch0 = (u.pn & 1) * BM + cl;
            const int ob = isq ? 0 : 1024;
#pragma unroll
            for (int ai = 0; ai < 2; ++ai)
#pragma unroll
                for (int m = 0; m < 4; ++m) { const size_t r = (size_t)(row0 + ai * HALF + m * 16);
#pragma unroll
                    for (int bj = 0; bj < 2; ++bj) { const int ch = ch0 + bj * HALF;
                        const f32x4 l0 = *(const f32x4*)(L + r * 512 + ch), l1 = *(const f32x4*)(L + r * 512 + ch + 4);
                        f32x4 v0 = acc[ai][bj][m][0] * sc, v1 = acc[ai][bj][m][1] * sc, p0, p1, n0, n1;
#pragma unroll
                        for (int e = 0; e < 4; ++e) { const float e0 = __expf(l0[e]), e1 = __expf(l1[e]); p0[e] = v0[e] * e0; p1[e] = v1[e] * e1; n0[e] = v0[e] * __expf(-l0[e]); n1[e] = v1[e] * __expf(-l1[e]); }
                        u32x4 w; w.x = cvt_pk_bf16(p0[0], p0[1]); w.y = cvt_pk_bf16(p0[2], p0[3]); w.z = cvt_pk_bf16(p1[0], p1[1]); w.w = cvt_pk_bf16(p1[2], p1[3]);
                        *(u32x4*)(O + r * 4096 + ob + ch) = w;
                        w.x = cvt_pk_bf16(n0[0], n0[1]); w.y = cvt_pk_bf16(n0[2], n0[3]); w.z = cvt_pk_bf16(n1[0], n1[1]); w.w = cvt_pk_bf16(n1[2], n1[3]);
                        *(u32x4*)(O + r * 4096 + ob + 512 + ch) = w; } }
        }
    }
};
template <class Epi, class Sched, bool ALIGN_EPI = false, bool SP2 = false>
__device__ __forceinline__ void gemm_phase(PG8_LAS unsigned char* lds, const Gemm g, const Sched& S, const Epi& E) {
    const int tid = tid_now(), wid = __builtin_amdgcn_readfirstlane(tid >> 6), lane = tid & 63, wr = wid >> 2, wc = wid & 3, fr = lane & 15, fq = lane >> 4;
    const int K = g.K, nt = K / BK;
    unsigned voffA[2], voffB[2];
#pragma unroll
    for (int i = 0; i < 2; ++i) { int R, C; stage_rc(tid * 16 + i * 8192, R, C); const int Rb = Epi::PERM ? ((R & ~31) + perm32(R & 31)) : R;
        voffA[i] = (unsigned)(R * K + C) * 2u; voffB[i] = (unsigned)(Rb * K + C) * 2u; }
    const size_t kstep = (size_t)(BK * 2);
    const size_t hstep = (size_t)HALF * K * 2;
    const size_t tstep = 2 * hstep;
    const unsigned ldsw = (unsigned)wid * 1024u;
    const int aoff = lds_byte(wr * 64 + fr, fq * 8), boff = lds_byte(wc * 32 + fr, fq * 8);
#define PG8_SA(b, h) (((b) * 2 + (h)) * HTB)
#define PG8_SB(b, h) ((4 + (b) * 2 + (h)) * HTB)
#define PG8_STAGE(bufoff, gbase, voff) do { _Pragma("unroll") for (int _i = 0; _i < 2; ++_i) \
        __builtin_amdgcn_global_load_lds((const unsigned*)((const char*)(gbase) + (voff)[_i]), (PG8_LAS unsigned*)(lds + (bufoff) + ldsw + _i * 8192), 16, 0, 0); } while (0)
#define PG8_LDA(dst, b, h) do { _Pragma("unroll") for (int m = 0; m < 4; ++m) _Pragma("unroll") for (int k = 0; k < 2; ++k) dst[m][k] = *(const PG8_LAS bf16x8*)(lds + PG8_SA(b, h) + aoff + m * 2048 + k * 1024); } while (0)
#define PG8_LDB(dst, b, h) do { _Pragma("unroll") for (int n = 0; n < 2; ++n) _Pragma("unroll") for (int k = 0; k < 2; ++k) dst[n][k] = *(const PG8_LAS bf16x8*)(lds + PG8_SB(b, h) + boff + n * 2048 + k * 1024); } while (0)
#define PG8_MMA(ai, bj, At, Bt) do { __builtin_amdgcn_s_setprio(1); _Pragma("unroll") for (int m = 0; m < 4; ++m) _Pragma("unroll") for (int n = 0; n < 2; ++n) _Pragma("unroll") for (int k = 0; k < 2; ++k) \
        acc[ai][bj][m][n] = __builtin_amdgcn_mfma_f32_16x16x32_bf16(Bt[n][k], At[m][k], acc[ai][bj][m][n], 0, 0, 0); __builtin_amdgcn_s_setprio(0); } while (0)
#define PG8_WAIT_V(n) asm volatile("s_waitcnt vmcnt(" #n ")" ::: "memory")
#define PG8_WAIT_L(n) asm volatile("s_waitcnt lgkmcnt(" #n ")" ::: "memory")
#define PG8_BAR __builtin_amdgcn_s_barrier()
#define PG8_SCHED __builtin_amdgcn_sched_barrier(0)
    Unit cur, nxt; int ui = 0;
    if (!S.next(0, cur)) return;
    f32x4 acc[2][2][4][2];
#pragma unroll
    for (int a = 0; a < 2; ++a)
#pragma unroll
        for (int b = 0; b < 2; ++b)
#pragma unroll
            for (int m = 0; m < 4; ++m)
#pragma unroll
                for (int n = 0; n < 2; ++n) acc[a][b][m][n] = (f32x4){0.f, 0.f, 0.f, 0.f};
    bf16x8 At[4][2], B0[2][2], B1[2][2];
    const char* cA = (const char*)g.A + (size_t)cur.pm * tstep; const char* cB = (const char*)g.Bt + (size_t)cur.pn * tstep;
    S.a_ready(cur);
    if constexpr (SP2) {
        PG8_STAGE(PG8_SB(0, 0), cB, voffB); PG8_STAGE(PG8_SB(0, 1), cB + hstep, voffB); PG8_STAGE(PG8_SA(0, 0), cA, voffA); PG8_STAGE(PG8_SA(0, 1), cA + hstep, voffA);
        if (wr == 1) PG8_BAR;
        PG8_WAIT_V(2); PG8_BAR;
        PG8_STAGE(PG8_SB(1, 0), cB + kstep, voffB); PG8_STAGE(PG8_SA(1, 0), cA + kstep, voffA); PG8_STAGE(PG8_SB(1, 1), cB + hstep + kstep, voffB);
        PG8_WAIT_V(6); PG8_BAR;
    } else {
        PG8_STAGE(PG8_SB(0, 0), cB, voffB); PG8_STAGE(PG8_SA(0, 0), cA, voffA); PG8_STAGE(PG8_SB(0, 1), cB + hstep, voffB); PG8_STAGE(PG8_SA(0, 1), cA + hstep, voffA);
        if (wr == 1) PG8_BAR;
        PG8_WAIT_V(4); PG8_BAR;
        PG8_STAGE(PG8_SB(1, 0), cB + kstep, voffB); PG8_STAGE(PG8_SA(1, 0), cA + kstep, voffA); PG8_STAGE(PG8_SB(1, 1), cB + hstep + kstep, voffB);
        PG8_WAIT_V(6); PG8_BAR;
    }
    for (;;) {
        const bool has_next = S.next(ui + 1, nxt);
        const char* nA = has_next ? (const char*)g.A + (size_t)nxt.pm * tstep : cA; const char* nB = has_next ? (const char*)g.Bt + (size_t)nxt.pn * tstep : cB;
        for (int t = 0; t < nt; t += 2) {
            const bool last = (t == nt - 2);
            const char* a1 = cA + (size_t)(t + 1) * kstep;
            const char* a2 = last ? nA : cA + (size_t)(t + 2) * kstep; const char* b2 = last ? nB : cB + (size_t)(t + 2) * kstep;
            const char* a3 = a2 + kstep; const char* b3 = b2 + kstep;
            if (last && has_next) S.a_ready(nxt);
            if constexpr (SP2) {
            PG8_LDB(B0, 0, 0); PG8_LDB(B1, 0, 1); PG8_SCHED; PG8_LDA(At, 0, 0); PG8_STAGE(PG8_SA(1, 1), a1 + hstep, voffA);
            PG8_WAIT_V(8); PG8_WAIT_L(0); PG8_BAR; PG8_MMA(0, 0, At, B0); PG8_MMA(0, 1, At, B1); PG8_BAR; PG8_SCHED;
            PG8_LDA(At, 0, 1); PG8_STAGE(PG8_SB(0, 0), b2, voffB); PG8_STAGE(PG8_SB(0, 1), b2 + hstep, voffB); PG8_STAGE(PG8_SA(0, 0), a2, voffA);
            PG8_WAIT_V(8); PG8_WAIT_L(0); PG8_BAR; PG8_MMA(1, 0, At, B0); PG8_MMA(1, 1, At, B1); PG8_BAR; PG8_SCHED;
            PG8_LDB(B0, 1, 0); PG8_LDB(B1, 1, 1); PG8_SCHED; PG8_LDA(At, 1, 0); PG8_STAGE(PG8_SA(0, 1), a2 + hstep, voffA);
            PG8_WAIT_V(8); PG8_WAIT_L(0); PG8_BAR; PG8_MMA(0, 0, At, B0); PG8_MMA(0, 1, At, B1); PG8_BAR; PG8_SCHED;
            PG8_LDA(At, 1, 1); PG8_STAGE(PG8_SB(1, 0), b3, voffB); PG8_STAGE(PG8_SB(1, 1), b3 + hstep, voffB); PG8_STAGE(PG8_SA(1, 0), a3, voffA);
            PG8_WAIT_V(8); PG8_WAIT_L(0); PG8_BAR; PG8_MMA(1, 0, At, B0); PG8_MMA(1, 1, At, B1); PG8_BAR; PG8_SCHED;
            } else {
            PG8_LDB(B0, 0, 0); PG8_SCHED; PG8_LDA(At, 0, 0); PG8_STAGE(PG8_SA(1, 1), a1 + hstep, voffA);
            PG8_WAIT_L(8); PG8_BAR; PG8_WAIT_L(0); PG8_MMA(0, 0, At, B0); PG8_BAR; PG8_SCHED;
            PG8_LDB(B1, 0, 1); PG8_STAGE(PG8_SB(0, 0), b2, voffB);
            PG8_BAR; PG8_WAIT_L(0); PG8_MMA(0, 1, At, B1); PG8_BAR;
            PG8_LDA(At, 0, 1); PG8_STAGE(PG8_SA(0, 0), a2, voffA);
            PG8_BAR; PG8_WAIT_L(0); PG8_MMA(1, 0, At, B0); PG8_BAR; PG8_SCHED;
            PG8_STAGE(PG8_SB(0, 1), b2 + hstep, voffB);
            PG8_WAIT_V(6); PG8_BAR; PG8_MMA(1, 1, At, B1); PG8_BAR;
            PG8_LDB(B0, 1, 0); PG8_SCHED; PG8_LDA(At, 1, 0); PG8_STAGE(PG8_SA(0, 1), a2 + hstep, voffA);
            PG8_WAIT_L(8); PG8_BAR; PG8_WAIT_L(0); PG8_MMA(0, 0, At, B0); PG8_BAR; PG8_SCHED;
            PG8_LDB(B1, 1, 1); PG8_STAGE(PG8_SB(1, 0), b3, voffB);
            PG8_BAR; PG8_WAIT_L(0); PG8_MMA(0, 1, At, B1); PG8_BAR;
            PG8_LDA(At, 1, 1); PG8_STAGE(PG8_SA(1, 0), a3, voffA);
            PG8_BAR; PG8_WAIT_L(0); PG8_MMA(1, 0, At, B0); PG8_BAR; PG8_SCHED;
            PG8_STAGE(PG8_SB(1, 1), b3 + hstep, voffB);
            PG8_WAIT_V(6); PG8_BAR; PG8_MMA(1, 1, At, B1); PG8_BAR;
            }
        }
        if constexpr (ALIGN_EPI) { if (wr == 0) PG8_BAR; }
        if constexpr (!Epi::AFTER_DRAIN) { E(acc, cur, wr, wc, fr, fq); S.done(cur); }
        if (!has_next) break;
#pragma unroll
        for (int a = 0; a < 2; ++a)
#pragma unroll
            for (int b = 0; b < 2; ++b)
#pragma unroll
                for (int m = 0; m < 4; ++m)
#pragma unroll
                    for (int n = 0; n < 2; ++n) acc[a][b][m][n] = (f32x4){0.f, 0.f, 0.f, 0.f};
        cur = nxt; cA = nA; cB = nB; ++ui;
        if constexpr (ALIGN_EPI) { if (wr == 1) PG8_BAR; }
    }
    PG8_WAIT_V(0);
    if constexpr (!ALIGN_EPI) { if (wr == 0) PG8_BAR; }
    PG8_BAR;
    if constexpr (Epi::AFTER_DRAIN) { E.fused(acc, cur, wr, wc, fr, fq, lds, wid, lane); S.done(cur); }
#undef PG8_SA
#undef PG8_SB
#undef PG8_STAGE
#undef PG8_LDA
#undef PG8_LDB
#undef PG8_MMA
#undef PG8_WAIT_V
#undef PG8_WAIT_L
#undef PG8_BAR
#undef PG8_SCHED
}
}

namespace mla {
typedef short bf16x8 __attribute__((ext_vector_type(8)));
typedef short s16x4 __attribute__((ext_vector_type(4)));
typedef float f32x16 __attribute__((ext_vector_type(16)));
typedef unsigned u32x4 __attribute__((ext_vector_type(4)));
typedef unsigned u32x2 __attribute__((ext_vector_type(2)));
constexpr int KRS = 400, VRS = 320;
constexpr int KT_BYTES = 64 * KRS, VT_BYTES = 64 * VRS, BUF_BYTES = KT_BYTES + VT_BYTES;
__device__ __forceinline__ unsigned cvtpk(float lo, float hi) { typedef float f2 __attribute__((ext_vector_type(2))); typedef __bf16 b2 __attribute__((ext_vector_type(2))); f2 v = {lo, hi}; b2 b = __builtin_convertvector(v, b2); return __builtin_bit_cast(unsigned, b); }
__device__ __forceinline__ float half_max(float v) { auto rr = __builtin_amdgcn_permlane32_swap(__float_as_uint(v), __float_as_uint(v), false, false); return fmaxf(__uint_as_float(rr[0]), __uint_as_float(rr[1])); }
__device__ __forceinline__ float half_sum(float v) { auto rr = __builtin_amdgcn_permlane32_swap(__float_as_uint(v), __float_as_uint(v), false, false); return __uint_as_float(rr[0]) + __uint_as_float(rr[1]); }

__device__ __forceinline__ void attn_unit(LAS unsigned char* lds, const bf16_t* __restrict__ q, const bf16_t* __restrict__ kv, const bf16_t* __restrict__ kr, bf16_t* __restrict__ o, int b, int h, int qb, int tid) {
    const int lane = tid & 63, wave = __builtin_amdgcn_readfirstlane(tid >> 6), r32 = lane & 31, hi = lane >> 5;
    const size_t row0 = (size_t)b * S; const int q0 = qb * 256;
    const int NT = 4 * qb + 4, my_nt = 4 * qb + (wave >> 1) + 1;
    bf16x8 qf[12];
    { const bf16_t* qp = q + (row0 + q0 + wave * 32 + r32) * (MH * MQK) + h * MQK + 8 * hi;
#pragma unroll
      for (int ks = 0; ks < 12; ++ks) qf[ks] = *(const bf16x8*)(qp + 16 * ks); }
    const int srow = tid >> 4, sch = tid & 15, rrow = tid >> 3, rch = tid & 7;
    const bf16_t* gk = kv + (row0 + srow) * (MH * 256) + h * 256 + sch * 8;
    const bf16_t* gr = kr + (row0 + rrow) * 64 + rch * 8;
    const unsigned dk0 = srow * KRS + sch * 16, dr0 = rrow * KRS + 256 + rch * 16, dv0 = KT_BYTES + srow * VRS + sch * 16;
    u32x4 st[5];
#define MLA_ISSUE(t) do { const bf16_t* gk_ = gk + (size_t)(t) * 64 * (MH * 256); st[0] = *(const u32x4*)(gk_); st[1] = *(const u32x4*)(gk_ + (size_t)32 * (MH * 256)); \
        st[2] = *(const u32x4*)(gr + (size_t)(t) * 64 * 64); st[3] = *(const u32x4*)(gk_ + 128); st[4] = *(const u32x4*)(gk_ + (size_t)32 * (MH * 256) + 128); } while (0)
#define MLA_COMMIT(buf) do { LAS unsigned char* b_ = lds + (buf) * BUF_BYTES; *(LAS u32x4*)(b_ + dk0) = st[0]; *(LAS u32x4*)(b_ + dk0 + 32 * KRS) = st[1]; *(LAS u32x4*)(b_ + dr0) = st[2]; \
        *(LAS u32x4*)(b_ + dv0) = st[3]; *(LAS u32x4*)(b_ + dv0 + 32 * VRS) = st[4]; } while (0)
    const unsigned ka = r32 * KRS + hi * 16;
    const unsigned va = KT_BYTES + (4 * hi + ((lane & 15) >> 2)) * VRS + (16 * ((lane >> 4) & 1) + 4 * (lane & 3)) * 2;
    float m = -1e30f, l = 0.f;
    f32x16 O[4];
#pragma unroll
    for (int d = 0; d < 4; ++d)
#pragma unroll
        for (int r = 0; r < 16; ++r) O[d][r] = 0.f;
    const float c = 0.072168783648703220564f * 1.4426950408889634f;
    MLA_ISSUE(0); MLA_COMMIT(0); if (NT > 1) MLA_ISSUE(1);
    __syncthreads();
    for (int t = 0; t < NT; ++t) {
        const int buf = t & 1;
        if (t + 1 < NT) MLA_COMMIT(buf ^ 1);
        if (t + 2 < NT) MLA_ISSUE(t + 2);
        if (t < my_nt) {
            LAS unsigned char* kb = lds + buf * BUF_BYTES;
            f32x16 s0, s1;
#pragma unroll
            for (int r = 0; r < 16; ++r) { s0[r] = 0.f; s1[r] = 0.f; }
#pragma unroll
            for (int ks = 0; ks < 12; ++ks) {
                const bf16x8 a0 = *(const LAS bf16x8*)(kb + ka + ks * 32), a1 = *(const LAS bf16x8*)(kb + ka + 32 * KRS + ks * 32);
                s0 = __builtin_amdgcn_mfma_f32_32x32x16_bf16(a0, qf[ks], s0, 0, 0, 0);
                s1 = __builtin_amdgcn_mfma_f32_32x32x16_bf16(a1, qf[ks], s1, 0, 0, 0);
            }
            float mx = fmaxf(s0[0], s1[0]);
#pragma unroll
            for (int r = 1; r < 16; ++r) mx = fmaxf(mx, fmaxf(s0[r], s1[r]));
            mx = half_max(mx);
            const float mn = fmaxf(m, mx * c), alpha = __builtin_amdgcn_exp2f(m - mn); m = mn;
            float ps = 0.f;
#pragma unroll
            for (int r = 0; r < 16; ++r) { s0[r] = __builtin_amdgcn_exp2f(s0[r] * c - mn); s1[r] = __builtin_amdgcn_exp2f(s1[r] * c - mn); ps += s0[r] + s1[r]; }
            l = l * alpha + ps;
#pragma unroll
            for (int d = 0; d < 4; ++d)
#pragma unroll
                for (int r = 0; r < 16; ++r) O[d][r] *= alpha;
            u32x4 pf[4];
#pragma unroll
            for (int s = 0; s < 2; ++s) {
                pf[s] = (u32x4){cvtpk(s0[8 * s], s0[8 * s + 1]), cvtpk(s0[8 * s + 2], s0[8 * s + 3]), cvtpk(s0[8 * s + 4], s0[8 * s + 5]), cvtpk(s0[8 * s + 6], s0[8 * s + 7])};
                pf[2 + s] = (u32x4){cvtpk(s1[8 * s], s1[8 * s + 1]), cvtpk(s1[8 * s + 2], s1[8 * s + 3]), cvtpk(s1[8 * s + 4], s1[8 * s + 5]), cvtpk(s1[8 * s + 6], s1[8 * s + 7])};
            }
#pragma unroll
            for (int d = 0; d < 4; ++d)
#pragma unroll
                for (int f = 0; f < 4; ++f) {
                    const s16x4 lo = __builtin_bit_cast(s16x4, __builtin_amdgcn_ds_read_tr16_b64_v4i16((LAS s16x4*)(kb + va + (16 * f) * VRS + d * 64)));
                    const s16x4 hh = __builtin_bit_cast(s16x4, __builtin_amdgcn_ds_read_tr16_b64_v4i16((LAS s16x4*)(kb + va + (16 * f + 8) * VRS + d * 64)));
                    const bf16x8 vt = (bf16x8){lo[0], lo[1], lo[2], lo[3], hh[0], hh[1], hh[2], hh[3]};
                    O[d] = __builtin_amdgcn_mfma_f32_32x32x16_bf16(vt, __builtin_bit_cast(bf16x8, pf[f]), O[d], 0, 0, 0);
                }
        }
        __syncthreads();
    }
#undef MLA_ISSUE
#undef MLA_COMMIT
    l = half_sum(l);
    const float inv = 1.f / l;
    bf16_t* op = o + (row0 + q0 + wave * 32 + r32) * (MH * MV) + h * MV + 4 * hi;
#pragma unroll
    for (int d = 0; d < 4; ++d)
#pragma unroll
        for (int g = 0; g < 4; ++g) { u32x2 w; w.x = cvtpk(O[d][4 * g] * inv, O[d][4 * g + 1] * inv); w.y = cvtpk(O[d][4 * g + 2] * inv, O[d][4 * g + 3] * inv); *(u32x2*)(op + 32 * d + 8 * g) = w; }
}
__device__ __forceinline__ void attn_phase(LAS unsigned char* lds, const bf16_t* q, const bf16_t* kv, const bf16_t* kr, bf16_t* o, int bid, int nblk, int tid) {
    for (int u = bid; u < NB * MH * 4; u += nblk) {
        const int bh = u >> 2, s = u & 3;
        attn_unit(lds, q, kv, kr, o, bh / MH, bh % MH, s, tid);
        attn_unit(lds, q, kv, kr, o, bh / MH, bh % MH, 7 - s, tid);
    }
}
}

namespace gla {
typedef short bf16x8 __attribute__((ext_vector_type(8)));
typedef float f32x4v __attribute__((ext_vector_type(4)));
__device__ __forceinline__ void l_units(LAS unsigned char* lds, const bf16_t* __restrict__ xb, const bf16_t* __restrict__ wlr, const float* __restrict__ wgu, const float* __restrict__ bg, float* __restrict__ L, float* __restrict__ DEC, int bid, int nblk, int tid) {
    const int lane = tid & 63, wave = __builtin_amdgcn_readfirstlane(tid >> 6), fr = lane & 15, fq = lane >> 4;
    LAS float* part = (LAS float*)lds;
    LAS float* G = (LAS float*)(lds + 32768);
    for (int cn = bid; cn < M / CH; cn += nblk) {
        const size_t m0 = (size_t)cn * CH;
        f32x4v acc[4];
#pragma unroll
        for (int rt = 0; rt < 4; ++rt) acc[rt] = (f32x4v){0.f, 0.f, 0.f, 0.f};
#pragma unroll
        for (int ks = 0; ks < 4; ++ks) {
            const int k0 = wave * 128 + ks * 32 + fq * 8;
            const bf16x8 bfrag = *(const bf16x8*)(wlr + (size_t)fr * D + k0);
#pragma unroll
            for (int rt = 0; rt < 4; ++rt) { const bf16x8 afrag = *(const bf16x8*)(xb + (m0 + rt * 16 + fr) * D + k0); acc[rt] = __builtin_amdgcn_mfma_f32_16x16x32_bf16(afrag, bfrag, acc[rt], 0, 0, 0); }
        }
#pragma unroll
        for (int rt = 0; rt < 4; ++rt)
#pragma unroll
            for (int e = 0; e < 4; ++e) part[(wave * 64 + rt * 16 + fq * 4 + e) * 16 + fr] = acc[rt][e];
        __syncthreads();
#pragma unroll
        for (int i = 0; i < 2; ++i) { const int o = tid + 512 * i; float s = 0.f;
#pragma unroll
            for (int w = 0; w < 8; ++w) s += part[w * 1024 + o];
            G[o] = s; }
        __syncthreads();
        const int ch = tid; float w[GRANK];
#pragma unroll
        for (int r = 0; r < GRANK; ++r) w[r] = wgu[r * GHK + ch];
        const float bias = bg[ch]; float run = 0.f;
        for (int t = 0; t < CH; ++t) {
            float z = bias;
#pragma unroll
            for (int r4 = 0; r4 < 4; ++r4) { const f32x4v g = *(const LAS f32x4v*)(G + t * 16 + r4 * 4); z += g[0] * w[4 * r4] + g[1] * w[4 * r4 + 1] + g[2] * w[4 * r4 + 2] + g[3] * w[4 * r4 + 3]; }
            run += log_sigmoid(z) * (1.f / 16.f);
            L[(m0 + t) * GHK + ch] = run;
        }
        DEC[(size_t)cn * GHK + ch] = expf(run);
        __syncthreads();
    }
}
}

namespace gla {
typedef short s16x4 __attribute__((ext_vector_type(4)));
typedef float f32x16 __attribute__((ext_vector_type(16)));
typedef unsigned u32x4 __attribute__((ext_vector_type(4)));
typedef unsigned u32x2 __attribute__((ext_vector_type(2)));
__device__ __forceinline__ unsigned cvtpk(float lo, float hi) { typedef float f2 __attribute__((ext_vector_type(2))); typedef __bf16 b2 __attribute__((ext_vector_type(2))); f2 v = {lo, hi}; b2 b = __builtin_convertvector(v, b2); return __builtin_bit_cast(unsigned, b); }
__device__ __forceinline__ float half_sum(float v) { auto rr = __builtin_amdgcn_permlane32_swap(__float_as_uint(v), __float_as_uint(v), false, false); return __uint_as_float(rr[0]) + __uint_as_float(rr[1]); }
__device__ __forceinline__ bf16x8 trfrag(LAS unsigned char* p0, LAS unsigned char* p1) {
    const s16x4 lo = __builtin_bit_cast(s16x4, __builtin_amdgcn_ds_read_tr16_b64_v4i16((LAS s16x4*)p0)), hh = __builtin_bit_cast(s16x4, __builtin_amdgcn_ds_read_tr16_b64_v4i16((LAS s16x4*)p1));
    return (bf16x8){lo[0], lo[1], lo[2], lo[3], hh[0], hh[1], hh[2], hh[3]};
}
constexpr int QRS = 272, VRS2 = 576;
constexpr int QT_BYTES = 64 * QRS, OFF_QP = 0, OFF_QN = QT_BYTES, OFF_KP = 2 * QT_BYTES, OFF_KN = 3 * QT_BYTES, OFF_V = 4 * QT_BYTES, OFF_SSQ = OFF_V + 64 * VRS2;
__device__ __forceinline__ void out_phase(LAS unsigned char* lds, const bf16_t* __restrict__ proj, const bf16_t* __restrict__ ST, const float* __restrict__ ng, bf16_t* __restrict__ og, int bid, int nblk, int tid) {
    const int lane = tid & 63, wave = __builtin_amdgcn_readfirstlane(tid >> 6), r32 = lane & 31, hi = lane >> 5;
    LAS float* SSQ = (LAS float*)(lds + OFF_SSQ);
    const unsigned qa = r32 * QRS + hi * 16;
    const unsigned va = OFF_V + (4 * hi + ((lane & 15) >> 2)) * VRS2 + (wave * 32 + 16 * ((lane >> 4) & 1) + 4 * (lane & 3)) * 2;
    for (int u = bid; u < NB * GH * NCH; u += nblk) {
        const int n = u % NCH, h = (u / NCH) % GH, b = u / (NCH * GH);
        const size_t m0 = (size_t)b * S + (size_t)n * CH;
        { u32x4 st[12];
#pragma unroll
          for (int i = 0; i < 8; ++i) { const int idx = tid + 512 * i, tile = idx >> 10, row = (idx >> 4) & 63, ch = idx & 15; st[i] = *(const u32x4*)(proj + (m0 + row) * 4096 + tile * 512 + h * GDK + ch * 8); }
#pragma unroll
          for (int i = 0; i < 4; ++i) { const int idx = tid + 512 * i, row = idx >> 5, ch = idx & 31; st[8 + i] = *(const u32x4*)(proj + (m0 + row) * 4096 + 2048 + h * GDV + ch * 8); }
#pragma unroll
          for (int i = 0; i < 8; ++i) { const int idx = tid + 512 * i, tile = idx >> 10, row = (idx >> 4) & 63, ch = idx & 15; *(LAS u32x4*)(lds + tile * QT_BYTES + row * QRS + ch * 16) = st[i]; }
#pragma unroll
          for (int i = 0; i < 4; ++i) { const int idx = tid + 512 * i, row = idx >> 5, ch = idx & 31; *(LAS u32x4*)(lds + OFF_V + row * VRS2 + ch * 16) = st[8 + i]; } }
        bf16x8 sf[8];
        { const bf16_t* sp = ST + ((size_t)u * GDV + wave * 32 + r32) * GDK + 8 * hi;
#pragma unroll
          for (int ks = 0; ks < 8; ++ks) sf[ks] = *(const bf16x8*)(sp + 16 * ks); }
        __syncthreads();
        f32x16 O[2];
#pragma unroll
        for (int tt = 0; tt < 2; ++tt) {
            bf16x8 qp[8], qn[8];
#pragma unroll
            for (int ks = 0; ks < 8; ++ks) { qp[ks] = *(const LAS bf16x8*)(lds + OFF_QP + tt * 32 * QRS + qa + ks * 32); qn[ks] = *(const LAS bf16x8*)(lds + OFF_QN + tt * 32 * QRS + qa + ks * 32); }
            u32x4 pf[4];
#pragma unroll
            for (int st_ = 0; st_ < 2; ++st_) {
                f32x16 p1, p2;
#pragma unroll
                for (int r = 0; r < 16; ++r) { p1[r] = 0.f; p2[r] = 0.f; }
                if (st_ <= tt) {
#pragma unroll
                    for (int ks = 0; ks < 8; ++ks) p1 = __builtin_amdgcn_mfma_f32_32x32x16_bf16(*(const LAS bf16x8*)(lds + OFF_KN + st_ * 32 * QRS + qa + ks * 32), qp[ks], p1, 0, 0, 0);
                }
                if (st_ >= tt) {
#pragma unroll
                    for (int ks = 0; ks < 8; ++ks) p2 = __builtin_amdgcn_mfma_f32_32x32x16_bf16(*(const LAS bf16x8*)(lds + OFF_KP + st_ * 32 * QRS + qa + ks * 32), qn[ks], p2, 0, 0, 0);
                }
                if (st_ == tt) {
#pragma unroll
                    for (int r = 0; r < 16; ++r) { const int srow = (r & 3) + 8 * (r >> 2) + 4 * hi; p1[r] = (r32 >= srow) ? p1[r] : p2[r]; }
                } else if (st_ > tt) p1 = p2;
#pragma unroll
                for (int s2 = 0; s2 < 2; ++s2) pf[st_ * 2 + s2] = (u32x4){cvtpk(p1[8 * s2], p1[8 * s2 + 1]), cvtpk(p1[8 * s2 + 2], p1[8 * s2 + 3]), cvtpk(p1[8 * s2 + 4], p1[8 * s2 + 5]), cvtpk(p1[8 * s2 + 6], p1[8 * s2 + 7])};
            }
            f32x16 o;
#pragma unroll
            for (int r = 0; r < 16; ++r) o[r] = 0.f;
#pragma unroll
            for (int f = 0; f < 4; ++f) o = __builtin_amdgcn_mfma_f32_32x32x16_bf16(trfrag(lds + va + (16 * f) * VRS2, lds + va + (16 * f + 8) * VRS2), __builtin_bit_cast(bf16x8, pf[f]), o, 0, 0, 0);
#pragma unroll
            for (int ks = 0; ks < 8; ++ks) o = __builtin_amdgcn_mfma_f32_32x32x16_bf16(sf[ks], qp[ks], o, 0, 0, 0);
            O[tt] = o;
            float ss = 0.f;
#pragma unroll
            for (int r = 0; r < 16; ++r) ss += o[r] * o[r];
            ss = half_sum(ss);
            if (hi == 0) SSQ[wave * 64 + tt * 32 + r32] = ss;
        }
        __syncthreads();
#pragma unroll
        for (int tt = 0; tt < 2; ++tt) {
            float tot = 0.f;
#pragma unroll
            for (int w = 0; w < 8; ++w) tot += SSQ[w * 64 + tt * 32 + r32];
            const float rstd = rsqrtf(tot * (1.f / GDV) + RMS_EPS);
            const size_t m = m0 + tt * 32 + r32;
#pragma unroll
            for (int g = 0; g < 4; ++g) { const int dv0 = wave * 32 + 8 * g + 4 * hi;
                const u32x2 rw = *(const u32x2*)(proj + m * 4096 + 3072 + h * GDV + dv0); const f32x4v gg = *(const f32x4v*)(ng + dv0);
                const float r0 = __uint_as_float(rw.x << 16), r1 = __uint_as_float(rw.x & 0xffff0000u), r2 = __uint_as_float(rw.y << 16), r3 = __uint_as_float(rw.y & 0xffff0000u);
                const float o0 = O[tt][4 * g] * rstd * gg[0] * (r0 / (1.f + __expf(-r0))), o1 = O[tt][4 * g + 1] * rstd * gg[1] * (r1 / (1.f + __expf(-r1)));
                const float o2 = O[tt][4 * g + 2] * rstd * gg[2] * (r2 / (1.f + __expf(-r2))), o3 = O[tt][4 * g + 3] * rstd * gg[3] * (r3 / (1.f + __expf(-r3)));
                u32x2 w; w.x = cvtpk(o0, o1); w.y = cvtpk(o2, o3); *(u32x2*)(og + m * GHV + h * GDV + dv0) = w; }
        }
        __syncthreads();
    }
}
}

namespace gla {
constexpr int SK_RS = 320, SV_RS = 64, SK_BYTES = 64 * SK_RS, SBUF = SK_BYTES + 64 * SV_RS;
__device__ __forceinline__ void state_phase(LAS unsigned char* lds, const bf16_t* __restrict__ proj, const float* __restrict__ DEC, bf16_t* __restrict__ ST, int bid, int nblk, int tid) {
    const int lane = tid & 63, wave = __builtin_amdgcn_readfirstlane(tid >> 6), r32 = lane & 31, hi = lane >> 5, i16 = lane & 15, g1 = (lane >> 4) & 1;
    for (int u = bid; u < NB * GH * 8; u += nblk) {
        const int dvs = u & 7, h = (u >> 3) & 3, b = u >> 5;
        const size_t mb = (size_t)b * S;
        const int krow = tid >> 4, kch = tid & 15, vrow = (tid >> 2) & 63, vch = tid & 3;
        const bf16_t* gk = proj + (mb + krow) * 4096 + 1536 + h * GDK + kch * 8;
        const bf16_t* gv = proj + (mb + vrow) * 4096 + 2048 + h * GDV + dvs * 32 + vch * 8;
        u32x4 st[3];
#define ST_ISSUE(n) do { st[0] = *(const u32x4*)(gk + (size_t)(n) * 64 * 4096); st[1] = *(const u32x4*)(gk + ((size_t)(n) * 64 + 32) * 4096); if (wave < 4) st[2] = *(const u32x4*)(gv + (size_t)(n) * 64 * 4096); } while (0)
#define ST_COMMIT(buf) do { LAS unsigned char* b_ = lds + (buf) * SBUF; *(LAS u32x4*)(b_ + krow * SK_RS + kch * 16) = st[0]; *(LAS u32x4*)(b_ + (krow + 32) * SK_RS + kch * 16) = st[1]; \
        if (wave < 4) *(LAS u32x4*)(b_ + SK_BYTES + vrow * SV_RS + vch * 16) = st[2]; } while (0)
        const unsigned aoff = SK_BYTES + (8 * hi + (i16 >> 2)) * SV_RS + (16 * g1 + 4 * (i16 & 3)) * 2;
        const unsigned boff = (8 * hi + (i16 >> 2)) * SK_RS + ((wave & 3) * 32 + 16 * g1 + 4 * (i16 & 3)) * 2;
        const float* dp = DEC + (size_t)b * NCH * GHK + h * GDK + (wave & 3) * 32 + r32;
        bf16_t* sp = ST + ((size_t)(b * GH + h) * NCH * GDV + dvs * 32 + 4 * hi) * GDK + (wave & 3) * 32 + r32;
        f32x16 acc;
#pragma unroll
        for (int r = 0; r < 16; ++r) acc[r] = 0.f;
        float dnext = dp[0];
        ST_ISSUE(0); ST_COMMIT(0); ST_ISSUE(1);
        __syncthreads();
        for (int n = 0; n < NCH; ++n) {
            const int buf = n & 1;
            if (n + 1 < NCH) ST_COMMIT(buf ^ 1);
            if (n + 2 < NCH) ST_ISSUE(n + 2);
            if (wave < 4) {
                const float dcur = dnext; if (n + 1 < NCH) dnext = dp[(size_t)(n + 1) * GHK];
                bf16_t* o = sp + (size_t)n * GDV * GDK;
#pragma unroll
                for (int r = 0; r < 16; ++r) o[(size_t)((r & 3) + 8 * (r >> 2)) * GDK] = (bf16_t)f2bf(acc[r]);
                LAS unsigned char* bb = lds + buf * SBUF;
#pragma unroll
                for (int ks = 0; ks < 4; ++ks) {
                    const bf16x8 af = trfrag(bb + aoff + (16 * ks) * SV_RS, bb + aoff + (16 * ks + 4) * SV_RS);
                    const bf16x8 bf = trfrag(bb + boff + (16 * ks) * SK_RS, bb + boff + (16 * ks + 4) * SK_RS);
                    acc = __builtin_amdgcn_mfma_f32_32x32x16_bf16(af, bf, acc, 0, 0, 0);
                }
#pragma unroll
                for (int r = 0; r < 16; ++r) acc[r] *= dcur;
            }
            __syncthreads();
        }
#undef ST_ISSUE
#undef ST_COMMIT
    }
}
}

typedef float f32x4 __attribute__((ext_vector_type(4)));
typedef unsigned v4u __attribute__((ext_vector_type(4)));
typedef unsigned v2u __attribute__((ext_vector_type(2)));
constexpr int NWAVES = 8, NTHREADS = 512;
constexpr int LDS_BYTES = 147456;
constexpr size_t MiB = 1u << 20;
constexpr size_t WS_CTL = 0, WS_CS = 1 * MiB, WS_WSET0 = 5 * MiB, WS_WSET1 = 32 * MiB, WS_B0 = 59 * MiB, WS_B1 = 91 * MiB, WS_BIG = 123 * MiB, WS_AUX = 251 * MiB, WS_PP = 299 * MiB, WS_GLR = 331 * MiB, WS_END = 332 * MiB;
constexpr size_t WO_IN = 0, WO_UQ = 786432, WO_UKV = 1179648, WO_OUT = 3145728, WO_W1 = 4194304, WO_W2 = 8388608, WO_G = 12582912, WO_P = 13631488, WO_LR = 13893632, WO_END = 13910016;
static_assert(WO_END * 2 <= 27 * MiB, "weight set fits its 27 MiB");

struct Args { const void* in[23]; float* out; unsigned char* ws; };

struct Ctx { int tid, lane, wave, gw, ngw, bid, nblk; LAS unsigned char* lds; };

__device__ __forceinline__ void tr_matrix(const Ctx& c, const float* W, int ldw, int K, int N, bf16_t* WT) {
    LAS float* scr = (LAS float*)(c.lds + c.wave * 16384);
    const int nblk = N / 32, nitems = (K / 64) * nblk, lane = c.lane;
    for (int it = c.gw; it < nitems; it += c.ngw) {
        const int kb = it / nblk, nb = it % nblk, k0 = 64 * kb, n0 = 32 * nb;
#pragma unroll 8
        for (int i = 0; i < 32; ++i) { const int kk = 2 * i + (lane >> 5); scr[kk * 33 + (lane & 31)] = W[(size_t)(k0 + kk) * ldw + n0 + (lane & 31)]; }
        asm volatile("s_waitcnt lgkmcnt(0)" ::: "memory");
        const int ch = lane & 7;
#pragma unroll
        for (int j = 0; j < 4; ++j) { const int n = (lane >> 3) + 8 * j; const LAS float* s = scr + (8 * ch) * 33 + n;
            v4u o; o.x = pk2(s[0 * 33], s[1 * 33]); o.y = pk2(s[2 * 33], s[3 * 33]); o.z = pk2(s[4 * 33], s[5 * 33]); o.w = pk2(s[6 * 33], s[7 * 33]);
            *(v4u*)(WT + (size_t)(n0 + n) * K + k0 + 8 * ch) = o; }
        asm volatile("s_waitcnt lgkmcnt(0)" ::: "memory");
    }
}
__device__ __forceinline__ void convert_weights(const Ctx& c, const Args& a, int i, bf16_t* WS) {
    const int j = i / 3, kind = i % 3;
    if (kind == 0) {
        tr_matrix(c, (const float*)a.in[3] + (size_t)j * D * GLA_IN, GLA_IN, D, 3072, WS + WO_IN);
        tr_matrix(c, (const float*)a.in[7] + (size_t)j * GHV * D, D, GHV, D, WS + WO_OUT);
        { const float* Wl = (const float*)a.in[3] + (size_t)j * D * GLA_IN + 3072;
          for (int e = c.bid * NTHREADS + c.tid; e < D * GRANK; e += c.nblk * NTHREADS) { const int k = e >> 4, n = e & 15; WS[WO_LR + (size_t)n * D + k] = (bf16_t)f2bf(Wl[(size_t)k * GLA_IN + n]); } }
    } else if (kind == 1) {
        tr_matrix(c, (const float*)a.in[8] + (size_t)j * D * MLA_IN, MLA_IN, D, MLA_IN, WS + WO_IN);
        { unsigned zz = 0u; asm volatile("" : "+v"(zz));
          for (size_t e = (size_t)c.bid * NTHREADS + c.tid; e < (size_t)(MLA_INP - MLA_IN) * D / 8; e += (size_t)c.nblk * NTHREADS) *((v4u*)(WS + WO_IN + (size_t)MLA_IN * D) + e) = (v4u){zz, zz, zz, zz}; }
        tr_matrix(c, (const float*)a.in[11] + (size_t)j * 256 * 1536, 1536, 256, 1536, WS + WO_UQ);
        tr_matrix(c, (const float*)a.in[12] + (size_t)j * 256 * 2048, 2048, 256, 2048, WS + WO_UKV);
        tr_matrix(c, (const float*)a.in[13] + (size_t)j * D * D, D, D, D, WS + WO_OUT);
    } else {
        tr_matrix(c, (const float*)a.in[14] + (size_t)j * D * 3 * D, 3 * D, D, 3 * D, WS + WO_IN);
        tr_matrix(c, (const float*)a.in[16] + (size_t)j * D * D, D, D, D, WS + WO_OUT);
    }
    tr_matrix(c, (const float*)a.in[19] + (size_t)i * D * FF, FF, D, FF, WS + WO_W1);
    tr_matrix(c, (const float*)a.in[20] + (size_t)i * FF * D, D, FF, D, WS + WO_W2);
    tr_matrix(c, (const float*)a.in[21] + (size_t)i * D * D, D, D, D, WS + WO_G);
    tr_matrix(c, (const float*)a.in[22] + (size_t)i * PLE * D, D, PLE, D, WS + WO_P);
}
__device__ __forceinline__ void cvt_rows(const Ctx& c, const float* src, bf16_t* dst, size_t n) {
    for (size_t e = (size_t)c.bid * NTHREADS + c.tid; e < n / 4; e += (size_t)c.nblk * NTHREADS) { const f32x4 v = ((const f32x4*)src)[e]; v2u o; o.x = pk2(v.x, v.y); o.y = pk2(v.z, v.w); ((v2u*)dst)[e] = o; }
}
__device__ __forceinline__ void ln_pass(const Ctx& c, float* X, const float* g, const float* b, bf16_t* xb) {
    for (int m = c.gw; m < M; m += c.ngw) {
        f32x4* xr = (f32x4*)(X + (size_t)m * D) + c.lane;
        f32x4 v[4]; float s = 0.f;
#pragma unroll
        for (int j = 0; j < 4; ++j) { v[j] = xr[64 * j]; s += (v[j].x + v[j].y) + (v[j].z + v[j].w); }
        const float mean = wave_sum(s) * (1.f / D); float s2 = 0.f;
#pragma unroll
        for (int j = 0; j < 4; ++j) { v[j] = v[j] - mean; s2 += (v[j].x * v[j].x + v[j].y * v[j].y) + (v[j].z * v[j].z + v[j].w * v[j].w); }
        const float rstd = 1.f / sqrtf(wave_sum(s2) * (1.f / D) + LN_EPS);
        v2u* o8 = (v2u*)(xb + (size_t)m * D) + c.lane;
#pragma unroll
        for (int j = 0; j < 4; ++j) { const f32x4 gg = ((const f32x4*)g)[c.lane + 64 * j], bb = ((const f32x4*)b)[c.lane + 64 * j]; const f32x4 o = v[j] * rstd * gg + bb;
            xr[64 * j] = o; v2u w; w.x = pk2(o.x, o.y); w.y = pk2(o.z, o.w); o8[64 * j] = w; }
    }
}


enum { T_NOP = 0, T_PROLOGUE, T_GEMM_BF16, T_GEMM_RELU2, T_GEMM_RES, T_GEMM_PLE, T_GLA_LUNIT, T_GLA_STATE, T_GLA_OUT, T_GEMM_GLA, T_MLA_PREP, T_MLA_QROPE, T_MLA_ATTN, T_CONVMIX, T_LN, T_PCVT, T_WCVT };
struct Op { int type, sync, n0, n1; const void *a0, *a1, *a2, *a3, *a4; void *o0, *o1, *o2; };

__device__ __forceinline__ int n_mixer_steps(int kind) { return kind == 2 ? 2 : (kind == 1 ? 6 : 4); }
__device__ __forceinline__ void decode(const Args& a, int i, int s, Op& op) {
    unsigned char* ws = a.ws;
    const int j = i / 3, kind = i % 3, nm = n_mixer_steps(kind);
    bf16_t* W = (bf16_t*)(ws + ((i & 1) ? WS_WSET1 : WS_WSET0));
    bf16_t* B0 = (bf16_t*)(ws + WS_B0); bf16_t* B1 = (bf16_t*)(ws + WS_B1); bf16_t* BIG = (bf16_t*)(ws + WS_BIG); bf16_t* AUX = (bf16_t*)(ws + WS_AUX); bf16_t* PP = (bf16_t*)(ws + WS_PP);
    float* XR = a.out; float* CS = (float*)(ws + WS_CS); float* GLR = (float*)(ws + WS_GLR);
    op.type = T_NOP; op.sync = 1; op.n0 = 0; op.n1 = 0; op.a0 = op.a1 = op.a2 = op.a3 = op.a4 = nullptr; op.o0 = op.o1 = op.o2 = nullptr;
    if (s < nm) {
        if (kind == 0) {
            bf16_t* PROJ = BIG; float* L = (float*)(ws + WS_B1); bf16_t* ST = AUX; float* DEC = GLR;
            switch (s) {
            case 0: op.type = T_GLA_LUNIT; op.a0 = B0; op.a1 = W + WO_LR; op.a2 = (const float*)a.in[4] + (size_t)j * GRANK * GHK; op.a3 = (const float*)a.in[5] + (size_t)j * GHK; op.o0 = L; op.o1 = DEC; break;
            case 1: op.type = T_GEMM_GLA; op.a0 = B0; op.a1 = W + WO_IN; op.n0 = 3072; op.n1 = D; op.o0 = PROJ; op.a2 = L; break;
            case 2: op.type = T_GLA_STATE; op.a0 = PROJ; op.a1 = DEC; op.o0 = ST; break;
            default: op.type = T_GLA_OUT; op.a0 = PROJ; op.a1 = ST; op.a2 = (const float*)a.in[6] + (size_t)j * GDV; op.o0 = B1; break;
            }
        } else if (kind == 1) {
            bf16_t* Cb = AUX; bf16_t* cqn = AUX + (size_t)12 * MiB; bf16_t* ckvn = AUX + (size_t)16 * MiB; bf16_t* kr = AUX + (size_t)20 * MiB;
            bf16_t* q = BIG; bf16_t* kv = BIG + (size_t)24 * MiB;
            switch (s) {
            case 0: op.type = T_GEMM_BF16; op.a0 = B0; op.a1 = W + WO_IN; op.n0 = MLA_INP; op.n1 = D; op.o0 = Cb; break;
            case 1: op.type = T_MLA_PREP; op.a0 = Cb; op.a1 = (const float*)a.in[9] + j * 256; op.a2 = (const float*)a.in[10] + j * 256; op.a3 = CS; op.o0 = cqn; op.o1 = ckvn; op.o2 = kr; break;
            case 2: op.type = T_GEMM_BF16; op.sync = 0; op.a0 = cqn; op.a1 = W + WO_UQ; op.n0 = 1536; op.n1 = 256; op.o0 = q; break;
            case 3: op.type = T_GEMM_BF16; op.a0 = ckvn; op.a1 = W + WO_UKV; op.n0 = 2048; op.n1 = 256; op.o0 = kv; break;
            case 4: op.type = T_MLA_QROPE; op.a0 = CS; op.o0 = q; break;
            default: op.type = T_MLA_ATTN; op.a0 = q; op.a1 = kv; op.a2 = kr; op.o0 = B1; break;
            }
        } else {
            if (s == 0) { op.type = T_GEMM_BF16; op.a0 = B0; op.a1 = W + WO_IN; op.n0 = 3 * D; op.n1 = D; op.o0 = BIG; }
            else { op.type = T_CONVMIX; op.a0 = BIG; op.a1 = (const float*)a.in[15] + (size_t)j * 3 * D; op.o0 = B1; }
        }
    } else {
        switch (s - nm) {
        case 0: op.type = T_GEMM_RES; op.a0 = B1; op.a1 = W + WO_OUT; op.n0 = D; op.n1 = D; op.a2 = (i == 0) ? (const float*)a.in[0] : XR; op.o0 = XR; break;
        case 1: op.type = T_LN; op.sync = 0; op.a0 = (const float*)a.in[17] + (size_t)(2 * i) * D; op.a1 = (const float*)a.in[18] + (size_t)(2 * i) * D; op.o0 = XR; op.o1 = B0; break;
        case 2: op.type = T_PCVT; op.sync = 0; op.a0 = (const float*)a.in[1] + (size_t)i * M * PLE; op.o0 = AUX; break;
        case 3: op.type = (i + 1 < DEPTH) ? T_WCVT : T_NOP; op.n0 = i + 1; op.o0 = ws + (((i + 1) & 1) ? WS_WSET1 : WS_WSET0); break;
        case 4: op.type = T_GEMM_RELU2; op.sync = 0; op.a0 = B0; op.a1 = W + WO_W1; op.n0 = FF; op.n1 = D; op.o0 = BIG; break;
        case 5: op.type = T_GEMM_BF16; op.a0 = AUX; op.a1 = W + WO_P; op.n0 = D; op.n1 = PLE; op.o0 = PP; break;
        case 6: op.type = T_GEMM_RES; op.a0 = BIG; op.a1 = W + WO_W2; op.n0 = D; op.n1 = FF; op.a2 = XR; op.o0 = XR; break;
        case 7: op.type = T_LN; op.a0 = (const float*)a.in[17] + (size_t)(2 * i + 1) * D; op.a1 = (const float*)a.in[18] + (size_t)(2 * i + 1) * D; op.o0 = XR; op.o1 = B1; break;
        default: op.type = T_GEMM_PLE; op.sync = (i + 1 < DEPTH) ? 1 : 0; op.a0 = B1; op.a1 = W + WO_G; op.n0 = D; op.n1 = D; op.a2 = PP; op.o0 = XR; op.o1 = B0; break;
        }
    }
}

#define RUN_GEMM(EPI_T, ...) do { pg8::Gemm g_{(const bf16_t*)op.a0, (const bf16_t*)op.a1, M, op.n0, op.n1}; pg8::StaticOrder S_; S_.init(M, op.n0, c.nblk, c.bid); \
    EPI_T E_{__VA_ARGS__}; pg8::gemm_phase<EPI_T, pg8::StaticOrder, true, true>(c.lds, g_, S_, E_); } while (0)

__global__ void __launch_bounds__(NTHREADS, 2) mega_fwd(Args a) {
    extern __shared__ __attribute__((aligned(16))) unsigned char lds_raw[];
    cg::grid_group grid = cg::this_grid();
    for (int i = -1; i < DEPTH; ++i) {
        const int ns = (i < 0) ? 1 : n_mixer_steps(i % 3) + 9;
        for (int s = 0; s < ns; ++s) {
            Ctx c; c.tid = tid_now(); c.bid = bid_now(); c.lane = c.tid & 63; c.wave = __builtin_amdgcn_readfirstlane(c.tid >> 6); c.nblk = nblk_now(); c.gw = c.bid * NWAVES + c.wave; c.ngw = c.nblk * NWAVES; c.lds = (LAS unsigned char*)lds_raw;
            Op op;
            if (i < 0) { op.type = T_PROLOGUE; op.sync = 1; op.n0 = op.n1 = 0; op.a0 = op.a1 = op.a2 = op.a3 = op.a4 = nullptr; op.o0 = op.o1 = op.o2 = nullptr; }
            else decode(a, i, s, op);
            switch (op.type) {
            case T_PROLOGUE: {
                const int* pos = (const int*)a.in[2]; float* CS = (float*)(a.ws + WS_CS);
                for (size_t e = (size_t)c.bid * NTHREADS + c.tid; e < (size_t)M * 32; e += (size_t)c.nblk * NTHREADS) {
                    const int jj = (int)(e & 31); const size_t m = e >> 5; const float ang = (float)pos[m] * inv_freq(jj);
                    float sn_, cs_; sincosf(ang, &sn_, &cs_); CS[m * 64 + jj] = cs_; CS[m * 64 + 32 + jj] = sn_;
                }
                cvt_rows(c, (const float*)a.in[0], (bf16_t*)(a.ws + WS_B0), (size_t)M * D);
                convert_weights(c, a, 0, (bf16_t*)(a.ws + WS_WSET0));
            } break;
            case T_GEMM_BF16: RUN_GEMM(pg8::EpiBf16<0>, (bf16_t*)op.o0, op.n0); break;
            case T_GEMM_RELU2: RUN_GEMM(pg8::EpiBf16<2>, (bf16_t*)op.o0, op.n0); break;
            case T_GEMM_RES: RUN_GEMM(pg8::EpiRes, (const float*)op.a2, (float*)op.o0, D, ALPHA); break;
            case T_GEMM_PLE: RUN_GEMM(pg8::EpiPle, (const float*)op.o0, (float*)op.o0, (const bf16_t*)op.a2, (bf16_t*)op.o1, D); break;
            case T_GLA_LUNIT: gla::l_units(c.lds, (const bf16_t*)op.a0, (const bf16_t*)op.a1, (const float*)op.a2, (const float*)op.a3, (float*)op.o0, (float*)op.o1, c.bid, c.nblk, c.tid); break;
            case T_GEMM_GLA: RUN_GEMM(pg8::EpiGla, (bf16_t*)op.o0, (const float*)op.a2); break;
            case T_GLA_STATE: gla::state_phase(c.lds, (const bf16_t*)op.a0, (const float*)op.a1, (bf16_t*)op.o0, c.bid, c.nblk, c.tid); break;
            case T_GLA_OUT: gla::out_phase(c.lds, (const bf16_t*)op.a0, (const bf16_t*)op.a1, (const float*)op.a2, (bf16_t*)op.o0, c.bid, c.nblk, c.tid); break;
            case T_MLA_PREP: mla_prep<bf16_t, bf16_t>((const bf16_t*)op.a0, MLA_INP, (const float*)op.a1, (const float*)op.a2, (const float*)op.a3, (bf16_t*)op.o0, (bf16_t*)op.o1, (bf16_t*)op.o2, M); break;
            case T_MLA_QROPE: mla_qrope<bf16_t>((bf16_t*)op.o0, (const float*)op.a0, M); break;
            case T_MLA_ATTN: mla::attn_phase(c.lds, (const bf16_t*)op.a0, (const bf16_t*)op.a1, (const bf16_t*)op.a2, (bf16_t*)op.o0, c.bid, c.nblk, c.tid); break;
            case T_CONVMIX: conv_mix<bf16_t, bf16_t>((const bf16_t*)op.a0, 3 * D, (const float*)op.a1, (bf16_t*)op.o0, M); break;
            case T_LN: ln_pass(c, (float*)op.o0, (const float*)op.a0, (const float*)op.a1, (bf16_t*)op.o1); break;
            case T_PCVT: cvt_rows(c, (const float*)op.a0, (bf16_t*)op.o0, (size_t)M * PLE); break;
            case T_WCVT: convert_weights(c, a, op.n0, (bf16_t*)op.o0); break;
            default: break;
            }
            if (op.sync) grid.sync();
        }
    }
}

extern "C" void kernel_launch(void* const* d_in, const int* in_sizes, int n_in, void* d_out, int out_size, void* d_ws, size_t ws_size, hipStream_t stream) {
    static int grid = 0;
    if (grid == 0) {
        if (n_in != 23 || out_size != M * D || ws_size < WS_END) { fprintf(stderr, "kernel_launch: unexpected shapes/workspace (n_in %d out %d ws %zu need %zu)\n", n_in, out_size, ws_size, (size_t)WS_END); grid = -1; return; }
        int dev = 0, cus = 0, per_cu = 0;
        (void)hipGetDevice(&dev); (void)hipDeviceGetAttribute(&cus, hipDeviceAttributeMultiprocessorCount, dev);
        if (hipFuncSetAttribute((const void*)mega_fwd, hipFuncAttributeMaxDynamicSharedMemorySize, LDS_BYTES) != hipSuccess) { fprintf(stderr, "kernel_launch: hipFuncSetAttribute failed\n"); grid = -1; return; }
        (void)hipOccupancyMaxActiveBlocksPerMultiprocessor(&per_cu, (const void*)mega_fwd, NTHREADS, LDS_BYTES);
        if (per_cu < 1) { fprintf(stderr, "kernel_launch: occupancy query says %d blocks per CU\n", per_cu); grid = -1; return; }
        grid = cus;
    }
    if (grid < 0) return;
    Args a{};
    for (int i = 0; i < 23; ++i) a.in[i] = d_in[i];
    a.out = (float*)d_out; a.ws = (unsigned char*)d_ws;
    void* args[] = {&a};
    hipError_t e = hipLaunchCooperativeKernel((const void*)mega_fwd, dim3(grid), dim3(NTHREADS), args, LDS_BYTES, stream);
    if (e != hipSuccess) fprintf(stderr, "cooperative launch failed: %s (grid %d)\n", hipGetErrorString(e), grid);
}
```

```cpp
#include <hip/hip_runtime.h>
#include <hip/hip_cooperative_groups.h>
#include <cstdint>
#include <cstdio>
namespace cg = cooperative_groups;

constexpr int NB = 8, S = 2048, D = 1024, M = NB * S, DEPTH = 4, CH = 64, NCH = S / CH;
constexpr int FF = 4096, PLE = 256;
constexpr int GLA_IN = 3088, GH = 4, GDK = 128, GDV = 256, GHK = 512, GHV = 1024, GRANK = 16;
constexpr int MLA_IN = 576, MLA_INP = 768, MH = 8, MNOPE = 128, MROPE = 64, MV = 128, MQK = 192;
constexpr float ALPHA = 1.6817928305074290860622509524664f;
constexpr float LN_EPS = 1e-5f, RMS_EPS = 1e-6f;

#define LAS __attribute__((address_space(3)))
typedef unsigned short bf16_t;
__device__ __forceinline__ float ldf(const float* p, size_t i) { return p[i]; }
__device__ __forceinline__ float ldf(const bf16_t* p, size_t i) { return __uint_as_float(((unsigned)p[i]) << 16); }
__device__ __forceinline__ unsigned f2bf(float f) { unsigned u = __float_as_uint(f); return (u + 0x7fffu + ((u >> 16) & 1u)) >> 16; }
__device__ __forceinline__ unsigned pk2(float lo, float hi) { return f2bf(lo) | (f2bf(hi) << 16); }
__device__ __forceinline__ float bflo(unsigned w) { return __uint_as_float(w << 16); }
__device__ __forceinline__ float bfhi(unsigned w) { return __uint_as_float(w & 0xffff0000u); }
__device__ __forceinline__ void stf(float* p, size_t i, float v) { p[i] = v; }
__device__ __forceinline__ void stf(bf16_t* p, size_t i, float v) { p[i] = (bf16_t)f2bf(v); }
__device__ __forceinline__ float wave_sum(float v) {
#pragma unroll
    for (int o = 1; o < 64; o <<= 1) v += __shfl_xor(v, o);
    return v;
}
__device__ __forceinline__ float wave_max(float v) {
#pragma unroll
    for (int o = 1; o < 64; o <<= 1) v = fmaxf(v, __shfl_xor(v, o));
    return v;
}
__device__ __forceinline__ float log_sigmoid(float z) { return fminf(z, 0.f) - log1pf(expf(-fabsf(z))); }
__device__ __forceinline__ float sigmoidf_(float z) { return 1.f / (1.f + expf(-z)); }
__device__ const float INV_FREQ[32] = {1.0f, 0.7498942017555237f, 0.5623413324356079f, 0.4216965138912201f, 0.3162277638912201f, 0.23713737726211548f, 0.17782793939113617f, 0.1333521455526352f, 0.10000000149011612f, 0.0749894231557846f, 0.05623413249850273f, 0.04216964915394783f, 0.03162277489900589f, 0.023713737726211548f, 0.017782794311642647f, 0.013335213996469975f, 0.009999999776482582f, 0.007498942315578461f, 0.005623413249850273f, 0.0042169648222625256f, 0.003162277629598975f, 0.0023713738191872835f, 0.0017782794311642647f, 0.0013335214462131262f, 0.0010000000474974513f, 0.0007498941849917173f, 0.000562341301701963f, 0.0004216965171508491f, 0.0003162277571391314f, 0.00023713737027719617f, 0.00017782794020604342f, 0.0001333521504420787f};
__device__ __forceinline__ float inv_freq(int j) { return INV_FREQ[j]; }

constexpr int NTHR = 512;
__device__ __forceinline__ int tid_now() { int t = threadIdx.x; asm volatile("" : "+v"(t)); return t; }
__device__ __forceinline__ int bid_now() { int b = blockIdx.x; asm volatile("" : "+s"(b)); return b; }
__device__ __forceinline__ int nblk_now() { int g = gridDim.x; asm volatile("" : "+s"(g)); return g; }
#define GSTRIDE(i, n) for (size_t i = (size_t)bid_now() * NTHR + tid_now(), _st = (size_t)nblk_now() * NTHR; i < (size_t)(n); i += _st)
#define WSTRIDE_DECL const int _t = tid_now(); const int lane = _t & 63; const size_t gw = ((size_t)bid_now() * NTHR + _t) >> 6, nw = ((size_t)nblk_now() * NTHR) >> 6

template <class T> __device__ __forceinline__ void gla_glr(const T* xb, const float* Win, float* glr, int Mloc) {
    WSTRIDE_DECL;
    for (size_t m = gw; m < (size_t)Mloc; m += nw) {
        float acc[GRANK];
#pragma unroll
        for (int r = 0; r < GRANK; ++r) acc[r] = 0.f;
        for (int i = 0; i < D / 64; ++i) { const int k = lane + 64 * i; const float xv = ldf(xb, m * D + k); const float* w = Win + (size_t)k * GLA_IN + 3072;
#pragma unroll
            for (int r = 0; r < GRANK; ++r) acc[r] += xv * w[r]; }
#pragma unroll
        for (int r = 0; r < GRANK; ++r) { const float s = wave_sum(acc[r]); if (lane == r) glr[m * GRANK + r] = s; }
    }
}
template <class T> __device__ __forceinline__ void gla_L(const T* glr, int ldg, const float* wgu, const float* bg, float* L, int Mloc) {
    GSTRIDE(idx, (size_t)(Mloc / CH) * GHK) {
        const int ch = (int)(idx % GHK); const int cn = (int)(idx / GHK);
        float acc = 0.f;
        for (int t = 0; t < CH; ++t) {
            const size_t m = (size_t)cn * CH + t; float z = bg[ch];
            for (int r = 0; r < GRANK; ++r) z += ldf(glr, m * ldg + r) * wgu[r * GHK + ch];
            acc += log_sigmoid(z) * (1.f / 16.f);
            L[m * GHK + ch] = acc;
        }
    }
}
template <class T, class TO> __device__ __forceinline__ void gla_state(const T* k, int ldk, const T* v, int ldv, const float* L, TO* ST, int nb) {
    GSTRIDE(idx, (size_t)nb * GH * GDK * GDV) {
        const int dv = (int)(idx % GDV), dk = (int)((idx / GDV) % GDK), h = (int)((idx / (GDV * GDK)) % GH), b = (int)(idx / ((size_t)GDV * GDK * GH));
        float st = 0.f;
        for (int n = 0; n < NCH; ++n) {
            stf(ST, (((size_t)(b * GH + h) * NCH + n) * GDK + dk) * GDV + dv, st);
            const size_t m0 = (size_t)b * S + n * CH;
            const float Lend = L[(m0 + CH - 1) * GHK + h * GDK + dk];
            float acc = 0.f;
            for (int s = 0; s < CH; ++s) { const size_t m = m0 + s; acc += ldf(k, m * ldk + h * GDK + dk) * expf(Lend - L[m * GHK + h * GDK + dk]) * ldf(v, m * ldv + h * GDV + dv); }
            st = expf(Lend) * st + acc;
        }
    }
}
template <class T> __device__ __forceinline__ void gla_scores(const T* q, int ldq, const T* k, int ldk, const float* L, float* SC, int nb) {
    GSTRIDE(idx, (size_t)nb * GH * NCH * CH * CH) {
        const int s = (int)(idx % CH), t = (int)((idx / CH) % CH); const size_t unit = idx / (CH * CH);
        const int n = (int)(unit % NCH), h = (int)((unit / NCH) % GH), b = (int)(unit / (NCH * GH));
        const size_t mt = (size_t)b * S + n * CH + t, ms = (size_t)b * S + n * CH + s;
        float acc = 0.f;
        for (int d = 0; d < GDK; ++d) acc += ldf(q, mt * ldq + h * GDK + d) * ldf(k, ms * ldk + h * GDK + d) * expf(-fabsf(L[mt * GHK + h * GDK + d] - L[ms * GHK + h * GDK + d]));
        SC[idx] = acc * 0.088388347648318440550f;
    }
}
template <class T, class TS, class TO> __device__ __forceinline__ void gla_out_norm(const T* q, int ldq, const T* v, int ldv, const T* r, int ldr, const float* L, const float* SC, const TS* ST, const float* g, TO* OG, int Mloc) {
    WSTRIDE_DECL;
    for (size_t it = gw; it < (size_t)Mloc * GH; it += nw) {
        const size_t m = it / GH; const int h = (int)(it % GH);
        const int b = (int)(m / S), tt = (int)(m % S), n = tt / CH, t = tt % CH;
        const size_t unit = (size_t)(b * GH + h) * NCH + n, m0 = (size_t)b * S + n * CH;
        float o[4] = {0.f, 0.f, 0.f, 0.f};
        for (int s = 0; s < CH; ++s) { const float sc = SC[(unit * CH + t) * CH + s];
#pragma unroll
            for (int j = 0; j < 4; ++j) o[j] += sc * ldf(v, (m0 + s) * ldv + h * GDV + lane + 64 * j); }
        float o2[4] = {0.f, 0.f, 0.f, 0.f};
        for (int dk = 0; dk < GDK; ++dk) { const float qe = ldf(q, m * ldq + h * GDK + dk) * expf(L[m * GHK + h * GDK + dk]);
#pragma unroll
            for (int j = 0; j < 4; ++j) o2[j] += qe * ldf(ST, (unit * GDK + dk) * GDV + lane + 64 * j); }
        float ss = 0.f;
#pragma unroll
        for (int j = 0; j < 4; ++j) { o[j] += o2[j] * 0.088388347648318440550f; ss += o[j] * o[j]; }
        const float rstd = rsqrtf(wave_sum(ss) * (1.f / GDV) + RMS_EPS);
#pragma unroll
        for (int j = 0; j < 4; ++j) { const int dv = lane + 64 * j; const float rv = ldf(r, m * ldr + h * GDV + dv); stf(OG, m * GHV + h * GDV + dv, o[j] * rstd * g[dv] * (rv * sigmoidf_(rv))); }
    }
}
template <class T, class TO> __device__ __forceinline__ void mla_prep(const T* Cb, int ldc, const float* qn, const float* kvn, const float* cs, TO* cqn, TO* ckvn, TO* kr, int Mloc) {
    WSTRIDE_DECL;
    for (size_t m = gw; m < (size_t)Mloc; m += nw) {
        float a[4], c[4], sa = 0.f, sc = 0.f;
#pragma unroll
        for (int j = 0; j < 4; ++j) { a[j] = ldf(Cb, m * ldc + lane + 64 * j); c[j] = ldf(Cb, m * ldc + 256 + lane + 64 * j); sa += a[j] * a[j]; sc += c[j] * c[j]; }
        const float ra = rsqrtf(wave_sum(sa) * (1.f / 256.f) + RMS_EPS), rc = rsqrtf(wave_sum(sc) * (1.f / 256.f) + RMS_EPS);
#pragma unroll
        for (int j = 0; j < 4; ++j) { const int d = lane + 64 * j; stf(cqn, m * 256 + d, a[j] * ra * qn[d]); stf(ckvn, m * 256 + d, c[j] * rc * kvn[d]); }
        if (lane < 32) {
            const float x1 = ldf(Cb, m * ldc + 512 + lane), x2 = ldf(Cb, m * ldc + 544 + lane);
            const float csn = cs[m * 64 + lane], sn = cs[m * 64 + 32 + lane];
            stf(kr, m * 64 + lane, x1 * csn - x2 * sn); stf(kr, m * 64 + 32 + lane, x2 * csn + x1 * sn);
        }
    }
}
template <class T> __device__ __forceinline__ void mla_qrope(T* q, const float* cs, int Mloc) {
    GSTRIDE(idx, (size_t)Mloc * MH * 32) {
        const int j = (int)(idx % 32), h = (int)((idx / 32) % MH); const size_t m = idx / (32 * MH);
        const size_t o = m * (MH * MQK) + h * MQK + MNOPE + j;
        const float x1 = ldf(q, o), x2 = ldf(q, o + 32);
        const float csn = cs[m * 64 + j], sn = cs[m * 64 + 32 + j];
        stf(q, o, x1 * csn - x2 * sn); stf(q, o + 32, x2 * csn + x1 * sn);
    }
}
template <class T, class TO> __device__ __forceinline__ void mla_attn(const T* q, const T* kv, const T* kr, TO* o, int nb, float* sc) {
    WSTRIDE_DECL;
    for (size_t it = gw; it < (size_t)nb * MH * S; it += nw) {
        const int qi = (int)(it % S), h = (int)((it / S) % MH), b = (int)(it / ((size_t)S * MH));
        const size_t m = (size_t)b * S + qi; const int lim = (qi / CH + 1) * CH;
        const T* qp = q + m * (MH * MQK) + h * MQK;
        float mx = -INFINITY;
        for (int s = lane; s < lim; s += 64) {
            const size_t ms = (size_t)b * S + s; const T* kp = kv + ms * (MH * 256) + h * 256; const T* rp = kr + ms * 64;
            float dot = 0.f;
            for (int d = 0; d < MNOPE; ++d) dot += ldf(qp, d) * ldf(kp, d);
            for (int j = 0; j < MROPE; ++j) dot += ldf(qp, MNOPE + j) * ldf(rp, j);
            dot *= 0.072168783648703220564f;
            sc[s] = dot; mx = fmaxf(mx, dot);
        }
        mx = wave_max(mx);
        float sum = 0.f;
        for (int s = lane; s < lim; s += 64) { const float p = expf(sc[s] - mx); sc[s] = p; sum += p; }
        sum = wave_sum(sum);
        __builtin_amdgcn_s_waitcnt(0); __builtin_amdgcn_wave_barrier();
        float a0 = 0.f, a1 = 0.f;
        for (int s = 0; s < lim; ++s) { const size_t ms = (size_t)b * S + s; const float p = sc[s]; a0 += p * ldf(kv, ms * (MH * 256) + h * 256 + 128 + lane); a1 += p * ldf(kv, ms * (MH * 256) + h * 256 + 192 + lane); }
        const float inv = 1.f / sum;
        stf(o, m * (MH * MV) + h * MV + lane, a0 * inv); stf(o, m * (MH * MV) + h * MV + 64 + lane, a1 * inv);
        __builtin_amdgcn_s_waitcnt(0); __builtin_amdgcn_wave_barrier();
    }
}
template <class T, class TO> __device__ __forceinline__ void conv_mix(const T* bcu, int ld, const float* cw, TO* a, int Mloc) {
    GSTRIDE(idx, (size_t)Mloc * D) {
        const int c = (int)(idx % D); const size_t m = idx / D; const int t = (int)(m % S);
        float z = 0.f;
#pragma unroll
        for (int j = 0; j < 3; ++j) { const int dt = 2 - j; if (t - dt >= 0) { const size_t mm = m - dt; z += cw[j * D + c] * ldf(bcu, mm * ld + D + c) * ldf(bcu, mm * ld + 2 * D + c); } }
        stf(a, idx, ldf(bcu, m * ld + c) * z);
    }
}

template <class T, class TO> __device__ __forceinline__ void gla_state2(const T* proj, const float* DEC, TO* ST, int nb) {
    GSTRIDE(idx, (size_t)nb * GH * GDK * GDV) {
        const int dk = (int)(idx % GDK), dv = (int)((idx / GDK) % GDV), h = (int)((idx / (GDV * GDK)) % GH), b = (int)(idx / ((size_t)GDV * GDK * GH));
        float st = 0.f;
        for (int n = 0; n < NCH; ++n) {
            stf(ST, (((size_t)(b * GH + h) * NCH + n) * GDV + dv) * GDK + dk, st);
            const size_t m0 = (size_t)b * S + n * CH; float acc = 0.f;
            for (int s = 0; s < CH; ++s) { const size_t m = m0 + s; acc += ldf(proj, m * 4096 + 1536 + h * GDK + dk) * ldf(proj, m * 4096 + 2048 + h * GDV + dv); }
            st = DEC[((size_t)b * NCH + n) * GHK + h * GDK + dk] * (st + acc);
        }
    }
}
namespace pg8 {
#define PG8_LAS __attribute__((address_space(3)))
typedef unsigned short bf16_t;
typedef short bf16x8 __attribute__((ext_vector_type(8)));
typedef float f32x4 __attribute__((ext_vector_type(4)));
typedef unsigned u32x4 __attribute__((ext_vector_type(4)));
constexpr int BM = 256, BK = 64, HALF = 128, HTB = HALF * BK * 2  , STAGE_BYTES = 8 * HTB, NXCD = 8, WGM = 8;

__host__ __device__ __forceinline__ int lds_byte(int r, int c) { const int st = (r >> 4) * 2 + (c >> 5), rr = r & 15, cc = c & 31, ob = rr * 64 + cc * 2; return st * 1024 + (ob ^ (((ob >> 9) & 1) << 5)); }
__host__ __device__ __forceinline__ void stage_rc(int b, int& R, int& C) { const int st = b / 1024, sb = b % 1024, swz = sb ^ (((sb >> 9) & 1) << 5); R = (st >> 1) * 16 + swz / 64; C = (st & 1) * 32 + (swz % 64) / 2; }
__host__ __device__ __forceinline__ int perm32(int rho) { const int n = rho >> 4, i = rho & 15; return 8 * (i >> 2) + 4 * n + (i & 3); }

struct Unit { int pm, pn; };
struct Gemm { const bf16_t* A; const bf16_t* Bt; int M, N, K; };

struct StaticOrder {
    int nM, nN, nwg, G, c;
    __host__ __device__ void init(int M, int N, int G_, int c_) { nM = M / BM; nN = N / BM; nwg = nM * nN; G = G_; c = c_; }
    __host__ __device__ bool next(int i, Unit& u) const {
        const long L = (long)i * G + c; if (L >= nwg) return false;
        int wgid = (int)L; { const int q = nwg / NXCD, r = nwg % NXCD, xcd = wgid % NXCD, off = wgid / NXCD; wgid = (xcd < r ? xcd * (q + 1) : r * (q + 1) + (xcd - r) * q) + off; }
        const int nig = WGM * nN, gid = wgid / nig, fm = gid * WGM, gsz = (nM - fm) < WGM ? (nM - fm) : WGM;
        u.pm = fm + ((wgid % nig) % gsz); u.pn = (wgid % nig) / gsz; return true;
    }
    __device__ __forceinline__ void a_ready(const Unit&) const {}
    __device__ __forceinline__ void done(const Unit&) const {}
};


__device__ __forceinline__ unsigned cvt_pk_bf16(float lo, float hi) { unsigned r; asm volatile("v_cvt_pk_bf16_f32 %0, %1, %2" : "=v"(r) : "v"(lo), "v"(hi)); return r; }
typedef unsigned u32x2 __attribute__((ext_vector_type(2)));
template <int ACT  > struct EpiBf16 {
    static constexpr bool PERM = true, AFTER_DRAIN = false;
    bf16_t* O; int ldc;
    __device__ __forceinline__ void operator()(const f32x4 (&acc)[2][2][4][2], const Unit& u, int wr, int wc, int fr, int fq) const {
        const int row0 = u.pm * BM + wr * 64 + fr, col0 = u.pn * BM + wc * 32 + 8 * fq;
#pragma unroll
        for (int ai = 0; ai < 2; ++ai)
#pragma unroll
            for (int m = 0; m < 4; ++m) { bf16_t* rowp = O + (size_t)(row0 + ai * HALF + m * 16) * ldc + col0;
#pragma unroll
                for (int bj = 0; bj < 2; ++bj) { f32x4 v0 = acc[ai][bj][m][0], v1 = acc[ai][bj][m][1];
                    if (ACT == 2) {
#pragma unroll
                        for (int e = 0; e < 4; ++e) { float a = fmaxf(v0[e], 0.f); v0[e] = a * a; float b = fmaxf(v1[e], 0.f); v1[e] = b * b; } }
                    u32x4 w; w.x = cvt_pk_bf16(v0[0], v0[1]); w.y = cvt_pk_bf16(v0[2], v0[3]); w.z = cvt_pk_bf16(v1[0], v1[1]); w.w = cvt_pk_bf16(v1[2], v1[3]);
                    *(u32x4*)(rowp + bj * HALF) = w; } }
    }
};
struct EpiRes {
    static constexpr bool PERM = false, AFTER_DRAIN = false;
    const float* base; float* out; int ldc; float alpha;
    __device__ __forceinline__ void operator()(const f32x4 (&acc)[2][2][4][2], const Unit& u, int wr, int wc, int fr, int fq) const {
        const int col0 = u.pn * BM + wc * 32 + 4 * fq;
#pragma unroll
        for (int ai = 0; ai < 2; ++ai)
#pragma unroll
            for (int m = 0; m < 4; ++m) { const size_t off = (size_t)(u.pm * BM + ai * HALF + wr * 64 + m * 16 + fr) * ldc + col0;
#pragma unroll
                for (int bj = 0; bj < 2; ++bj)
#pragma unroll
                    for (int n = 0; n < 2; ++n) { const f32x4 bs = *(const f32x4*)(base + off + bj * HALF + n * 16); *(f32x4*)(out + off + bj * HALF + n * 16) = bs * alpha + acc[ai][bj][m][n]; } }
    }
};
struct EpiPle {
    static constexpr bool PERM = false, AFTER_DRAIN = false;
    const float* xin; float* xout; const bf16_t* P; bf16_t* xb; int ldc;
    __device__ __forceinline__ void operator()(const f32x4 (&acc)[2][2][4][2], const Unit& u, int wr, int wc, int fr, int fq) const {
        const int col0 = u.pn * BM + wc * 32 + 4 * fq;
#pragma unroll
        for (int ai = 0; ai < 2; ++ai)
#pragma unroll
            for (int m = 0; m < 4; ++m) { const size_t off = (size_t)(u.pm * BM + ai * HALF + wr * 64 + m * 16 + fr) * ldc + col0;
#pragma unroll
                for (int bj = 0; bj < 2; ++bj)
#pragma unroll
                    for (int n = 0; n < 2; ++n) { const size_t o = off + bj * HALF + n * 16; const f32x4 x2 = *(const f32x4*)(xin + o); const u32x2 pw = *(const u32x2*)(P + o); const f32x4 a = acc[ai][bj][m][n];
                        f32x4 r; r[0] = x2[0] + __uint_as_float(pw.x << 16) / (1.f + __expf(-a[0])); r[1] = x2[1] + __uint_as_float(pw.x & 0xffff0000u) / (1.f + __expf(-a[1]));
                        r[2] = x2[2] + __uint_as_float(pw.y << 16) / (1.f + __expf(-a[2])); r[3] = x2[3] + __uint_as_float(pw.y & 0xffff0000u) / (1.f + __expf(-a[3]));
                        *(f32x4*)(xout + o) = r; u32x2 w; w.x = cvt_pk_bf16(r[0], r[1]); w.y = cvt_pk_bf16(r[2], r[3]); *(u32x2*)(xb + o) = w; } }
    }
};

struct EpiGla {
    static constexpr bool PERM = true, AFTER_DRAIN = false;
    bf16_t* O; const float* L;
    __device__ __forceinline__ void operator()(const f32x4 (&acc)[2][2][4][2], const Unit& u, int wr, int wc, int fr, int fq) const {
        const int row0 = u.pm * BM + wr * 64 + fr, cl = wc * 32 + 8 * fq;
        if (u.pn >= 4) {
#pragma unroll
            for (int ai = 0; ai < 2; ++ai)
#pragma unroll
                for (int m = 0; m < 4; ++m) { bf16_t* rowp = O + (size_t)(row0 + ai * HALF + m * 16) * 4096 + 1024 + u.pn * BM + cl;
#pragma unroll
                    for (int bj = 0; bj < 2; ++bj) { const f32x4 v0 = acc[ai][bj][m][0], v1 = acc[ai][bj][m][1];
                        u32x4 w; w.x = cvt_pk_bf16(v0[0], v0[1]); w.y = cvt_pk_bf16(v0[2], v0[3]); w.z = cvt_pk_bf16(v1[0], v1[1]); w.w = cvt_pk_bf16(v1[2], v1[3]);
                        *(u32x4*)(rowp + bj * HALF) = w; } }
        } else {
            const bool isq = u.pn < 2; const float sc = isq ? 0.088388347648318440550f : 1.f;
            const int ch0 = (u.pn & 1) * BM + cl;
            const int ob = isq ? 0 : 1024;
#pragma unroll
            for (int ai = 0; ai < 2; ++ai)
#pragma unroll
                for (int m = 0; m < 4; ++m) { const size_t r = (size_t)(row0 + ai * HALF + m * 16);
#pragma unroll
                    for (int bj = 0; bj < 2; ++bj) { const int ch = ch0 + bj * HALF;
                        const f32x4 l0 = *(const f32x4*)(L + r * 512 + ch), l1 = *(const f32x4*)(L + r * 512 + ch + 4);
                        f32x4 v0 = acc[ai][bj][m][0] * sc, v1 = acc[ai][bj][m][1] * sc, p0, p1, n0, n1;
#pragma unroll
                        for (int e = 0; e < 4; ++e) { const float e0 = __expf(l0[e]), e1 = __expf(l1[e]); p0[e] = v0[e] * e0; p1[e] = v1[e] * e1; n0[e] = v0[e] * __expf(-l0[e]); n1[e] = v1[e] * __expf(-l1[e]); }
                        u32x4 w; w.x = cvt_pk_bf16(p0[0], p0[1]); w.y = cvt_pk_bf16(p0[2], p0[3]); w.z = cvt_pk_bf16(p1[0], p1[1]); w.w = cvt_pk_bf16(p1[2], p1[3]);
                        *(u32x4*)(O + r * 4096 + ob + ch) = w;
                        w.x = cvt_pk_bf16(n0[0], n0[1]); w.y = cvt_pk_bf16(n0[2], n0[3]); w.z = cvt_pk_bf16(n1[0], n1[1]); w.w = cvt_pk_bf16(n1[2], n1[3]);
                        *(u32x4*)(O + r * 4096 + ob + 512 + ch) = w; } }
        }
    }
};
template <class Epi, class Sched, bool ALIGN_EPI = false, bool SP2 = false>
__device__ __forceinline__ void gemm_phase(PG8_LAS unsigned char* lds, const Gemm g, const Sched& S, const Epi& E) {
    const int tid = tid_now(), wid = __builtin_amdgcn_readfirstlane(tid >> 6), lane = tid & 63, wr = wid >> 2, wc = wid & 3, fr = lane & 15, fq = lane >> 4;
    const int K = g.K, nt = K / BK;
    unsigned voffA[2], voffB[2];
#pragma unroll
    for (int i = 0; i < 2; ++i) { int R, C; stage_rc(tid * 16 + i * 8192, R, C); const int Rb = Epi::PERM ? ((R & ~31) + perm32(R & 31)) : R;
        voffA[i] = (unsigned)(R * K + C) * 2u; voffB[i] = (unsigned)(Rb * K + C) * 2u; }
    const size_t kstep = (size_t)(BK * 2);
    const size_t hstep = (size_t)HALF * K * 2;
    const size_t tstep = 2 * hstep;
    const unsigned ldsw = (unsigned)wid * 1024u;
    const int aoff = lds_byte(wr * 64 + fr, fq * 8), boff = lds_byte(wc * 32 + fr, fq * 8);
#define PG8_SA(b, h) (((b) * 2 + (h)) * HTB)
#define PG8_SB(b, h) ((4 + (b) * 2 + (h)) * HTB)
#define PG8_STAGE(bufoff, gbase, voff) do { _Pragma("unroll") for (int _i = 0; _i < 2; ++_i) \
        __builtin_amdgcn_global_load_lds((const unsigned*)((const char*)(gbase) + (voff)[_i]), (PG8_LAS unsigned*)(lds + (bufoff) + ldsw + _i * 8192), 16, 0, 0); } while (0)
#define PG8_LDA(dst, b, h) do { _Pragma("unroll") for (int m = 0; m < 4; ++m) _Pragma("unroll") for (int k = 0; k < 2; ++k) dst[m][k] = *(const PG8_LAS bf16x8*)(lds + PG8_SA(b, h) + aoff + m * 2048 + k * 1024); } while (0)
#define PG8_LDB(dst, b, h) do { _Pragma("unroll") for (int n = 0; n < 2; ++n) _Pragma("unroll") for (int k = 0; k < 2; ++k) dst[n][k] = *(const PG8_LAS bf16x8*)(lds + PG8_SB(b, h) + boff + n * 2048 + k * 1024); } while (0)
#define PG8_MMA(ai, bj, At, Bt) do { __builtin_amdgcn_s_setprio(1); _Pragma("unroll") for (int m = 0; m < 4; ++m) _Pragma("unroll") for (int n = 0; n < 2; ++n) _Pragma("unroll") for (int k = 0; k < 2; ++k) \
        acc[ai][bj][m][n] = __builtin_amdgcn_mfma_f32_16x16x32_bf16(Bt[n][k], At[m][k], acc[ai][bj][m][n], 0, 0, 0); __builtin_amdgcn_s_setprio(0); } while (0)
#define PG8_WAIT_V(n) asm volatile("s_waitcnt vmcnt(" #n ")" ::: "memory")
#define PG8_WAIT_L(n) asm volatile("s_waitcnt lgkmcnt(" #n ")" ::: "memory")
#define PG8_BAR __builtin_amdgcn_s_barrier()
#define PG8_SCHED __builtin_amdgcn_sched_barrier(0)
    Unit cur, nxt; int ui = 0;
    if (!S.next(0, cur)) return;
    f32x4 acc[2][2][4][2];
#pragma unroll
    for (int a = 0; a < 2; ++a)
#pragma unroll
        for (int b = 0; b < 2; ++b)
#pragma unroll
            for (int m = 0; m < 4; ++m)
#pragma unroll
                for (int n = 0; n < 2; ++n) acc[a][b][m][n] = (f32x4){0.f, 0.f, 0.f, 0.f};
    bf16x8 At[4][2], B0[2][2], B1[2][2];
    const char* cA = (const char*)g.A + (size_t)cur.pm * tstep; const char* cB = (const char*)g.Bt + (size_t)cur.pn * tstep;
    S.a_ready(cur);
    if constexpr (SP2) {
        PG8_STAGE(PG8_SB(0, 0), cB, voffB); PG8_STAGE(PG8_SB(0, 1), cB + hstep, voffB); PG8_STAGE(PG8_SA(0, 0), cA, voffA); PG8_STAGE(PG8_SA(0, 1), cA + hstep, voffA);
        if (wr == 1) PG8_BAR;
        PG8_WAIT_V(2); PG8_BAR;
        PG8_STAGE(PG8_SB(1, 0), cB + kstep, voffB); PG8_STAGE(PG8_SA(1, 0), cA + kstep, voffA); PG8_STAGE(PG8_SB(1, 1), cB + hstep + kstep, voffB);
        PG8_WAIT_V(6); PG8_BAR;
    } else {
        PG8_STAGE(PG8_SB(0, 0), cB, voffB); PG8_STAGE(PG8_SA(0, 0), cA, voffA); PG8_STAGE(PG8_SB(0, 1), cB + hstep, voffB); PG8_STAGE(PG8_SA(0, 1), cA + hstep, voffA);
        if (wr == 1) PG8_BAR;
        PG8_WAIT_V(4); PG8_BAR;
        PG8_STAGE(PG8_SB(1, 0), cB + kstep, voffB); PG8_STAGE(PG8_SA(1, 0), cA + kstep, voffA); PG8_STAGE(PG8_SB(1, 1), cB + hstep + kstep, voffB);
        PG8_WAIT_V(6); PG8_BAR;
    }
    for (;;) {
        const bool has_next = S.next(ui + 1, nxt);
        const char* nA = has_next ? (const char*)g.A + (size_t)nxt.pm * tstep : cA; const char* nB = has_next ? (const char*)g.Bt + (size_t)nxt.pn * tstep : cB;
        for (int t = 0; t < nt; t += 2) {
            const bool last = (t == nt - 2);
            const char* a1 = cA + (size_t)(t + 1) * kstep;
            const char* a2 = last ? nA : cA + (size_t)(t + 2) * kstep; const char* b2 = last ? nB : cB + (size_t)(t + 2) * kstep;
            const char* a3 = a2 + kstep; const char* b3 = b2 + kstep;
            if (last && has_next) S.a_ready(nxt);
            if constexpr (SP2) {
            PG8_LDB(B0, 0, 0); PG8_LDB(B1, 0, 1); PG8_SCHED; PG8_LDA(At, 0, 0); PG8_STAGE(PG8_SA(1, 1), a1 + hstep, voffA);
            PG8_WAIT_V(8); PG8_WAIT_L(0); PG8_BAR; PG8_MMA(0, 0, At, B0); PG8_MMA(0, 1, At, B1); PG8_BAR; PG8_SCHED;
            PG8_LDA(At, 0, 1); PG8_STAGE(PG8_SB(0, 0), b2, voffB); PG8_STAGE(PG8_SB(0, 1), b2 + hstep, voffB); PG8_STAGE(PG8_SA(0, 0), a2, voffA);
            PG8_WAIT_V(8); PG8_WAIT_L(0); PG8_BAR; PG8_MMA(1, 0, At, B0); PG8_MMA(1, 1, At, B1); PG8_BAR; PG8_SCHED;
            PG8_LDB(B0, 1, 0); PG8_LDB(B1, 1, 1); PG8_SCHED; PG8_LDA(At, 1, 0); PG8_STAGE(PG8_SA(0, 1), a2 + hstep, voffA);
            PG8_WAIT_V(8); PG8_WAIT_L(0); PG8_BAR; PG8_MMA(0, 0, At, B0); PG8_MMA(0, 1, At, B1); PG8_BAR; PG8_SCHED;
            PG8_LDA(At, 1, 1); PG8_STAGE(PG8_SB(1, 0), b3, voffB); PG8_STAGE(PG8_SB(1, 1), b3 + hstep, voffB); PG8_STAGE(PG8_SA(1, 0), a3, voffA);
            PG8_WAIT_V(8); PG8_WAIT_L(0); PG8_BAR; PG8_MMA(1, 0, At, B0); PG8_MMA(1, 1, At, B1); PG8_BAR; PG8_SCHED;
            } else {
            PG8_LDB(B0, 0, 0); PG8_SCHED; PG8_LDA(At, 0, 0); PG8_STAGE(PG8_SA(1, 1), a1 + hstep, voffA);
            PG8_WAIT_L(8); PG8_BAR; PG8_WAIT_L(0); PG8_MMA(0, 0, At, B0); PG8_BAR; PG8_SCHED;
            PG8_LDB(B1, 0, 1); PG8_STAGE(PG8_SB(0, 0), b2, voffB);
            PG8_BAR; PG8_WAIT_L(0); PG8_MMA(0, 1, At, B1); PG8_BAR;
            PG8_LDA(At, 0, 1); PG8_STAGE(PG8_SA(0, 0), a2, voffA);
            PG8_BAR; PG8_WAIT_L(0); PG8_MMA(1, 0, At, B0); PG8_BAR; PG8_SCHED;
            PG8_STAGE(PG8_SB(0, 1), b2 + hstep, voffB);
            PG8_WAIT_V(6); PG8_BAR; PG8_MMA(1, 1, At, B1); PG8_BAR;
            PG8_LDB(B0, 1, 0); PG8_SCHED; PG8_LDA(At, 1, 0); PG8_STAGE(PG8_SA(0, 1), a2 + hstep, voffA);
            PG8_WAIT_L(8); PG8_BAR; PG8_WAIT_L(0); PG8_MMA(0, 0, At, B0); PG8_BAR; PG8_SCHED;
            PG8_LDB(B1, 1, 1); PG8_STAGE(PG8_SB(1, 0), b3, voffB);
            PG8_BAR; PG8_WAIT_L(0); PG8_MMA(0, 1, At, B1); PG8_BAR;
            PG8_LDA(At, 1, 1); PG8_STAGE(PG8_SA(1, 0), a3, voffA);
            PG8_BAR; PG8_WAIT_L(0); PG8_MMA(1, 0, At, B0); PG8_BAR; PG8_SCHED;
            PG8_STAGE(PG8_SB(1, 1), b3 + hstep, voffB);
            PG8_WAIT_V(6); PG8_BAR; PG8_MMA(1, 1, At, B1); PG8_BAR;
            }
        }
        if constexpr (ALIGN_EPI) { if (wr == 0) PG8_BAR; }
        if constexpr (!Epi::AFTER_DRAIN) { E(acc, cur, wr, wc, fr, fq); S.done(cur); }
        if (!has_next) break;
#pragma unroll
        for (int a = 0; a < 2; ++a)
#pragma unroll
            for (int b = 0; b < 2; ++b)
#pragma unroll
                for (int m = 0; m < 4; ++m)
#pragma unroll
                    for (int n = 0; n < 2; ++n) acc[a][b][m][n] = (f32x4){0.f, 0.f, 0.f, 0.f};
        cur = nxt; cA = nA; cB = nB; ++ui;
        if constexpr (ALIGN_EPI) { if (wr == 1) PG8_BAR; }
    }
    PG8_WAIT_V(0);
    if constexpr (!ALIGN_EPI) { if (wr == 0) PG8_BAR; }
    PG8_BAR;
    if constexpr (Epi::AFTER_DRAIN) { E.fused(acc, cur, wr, wc, fr, fq, lds, wid, lane); S.done(cur); }
#undef PG8_SA
#undef PG8_SB
#undef PG8_STAGE
#undef PG8_LDA
#undef PG8_LDB
#undef PG8_MMA
#undef PG8_WAIT_V
#undef PG8_WAIT_L
#undef PG8_BAR
#undef PG8_SCHED
}
}

namespace mla {
typedef short bf16x8 __attribute__((ext_vector_type(8)));
typedef short s16x4 __attribute__((ext_vector_type(4)));
typedef float f32x16 __attribute__((ext_vector_type(16)));
typedef unsigned u32x4 __attribute__((ext_vector_type(4)));
typedef unsigned u32x2 __attribute__((ext_vector_type(2)));
constexpr int KRS = 400, VRS = 320;
constexpr int KT_BYTES = 64 * KRS, VT_BYTES = 64 * VRS, BUF_BYTES = KT_BYTES + VT_BYTES;
__device__ __forceinline__ unsigned cvtpk(float lo, float hi) { typedef float f2 __attribute__((ext_vector_type(2))); typedef __bf16 b2 __attribute__((ext_vector_type(2))); f2 v = {lo, hi}; b2 b = __builtin_convertvector(v, b2); return __builtin_bit_cast(unsigned, b); }
__device__ __forceinline__ float half_max(float v) { auto rr = __builtin_amdgcn_permlane32_swap(__float_as_uint(v), __float_as_uint(v), false, false); return fmaxf(__uint_as_float(rr[0]), __uint_as_float(rr[1])); }
__device__ __forceinline__ float half_sum(float v) { auto rr = __builtin_amdgcn_permlane32_swap(__float_as_uint(v), __float_as_uint(v), false, false); return __uint_as_float(rr[0]) + __uint_as_float(rr[1]); }

__device__ __forceinline__ void attn_unit(LAS unsigned char* lds, const bf16_t* __restrict__ q, const bf16_t* __restrict__ kv, const bf16_t* __restrict__ kr, bf16_t* __restrict__ o, int b, int h, int qb, int tid) {
    const int lane = tid & 63, wave = __builtin_amdgcn_readfirstlane(tid >> 6), r32 = lane & 31, hi = lane >> 5;
    const size_t row0 = (size_t)b * S; const int q0 = qb * 256;
    const int NT = 4 * qb + 4, my_nt = 4 * qb + (wave >> 1) + 1;
    bf16x8 qf[12];
    { const bf16_t* qp = q + (row0 + q0 + wave * 32 + r32) * (MH * MQK) + h * MQK + 8 * hi;
#pragma unroll
      for (int ks = 0; ks < 12; ++ks) qf[ks] = *(const bf16x8*)(qp + 16 * ks); }
    const int srow = tid >> 4, sch = tid & 15, rrow = tid >> 3, rch = tid & 7;
    const bf16_t* gk = kv + (row0 + srow) * (MH * 256) + h * 256 + sch * 8;
    const bf16_t* gr = kr + (row0 + rrow) * 64 + rch * 8;
    const unsigned dk0 = srow * KRS + sch * 16, dr0 = rrow * KRS + 256 + rch * 16, dv0 = KT_BYTES + srow * VRS + sch * 16;
    u32x4 st[5];
#define MLA_ISSUE(t) do { const bf16_t* gk_ = gk + (size_t)(t) * 64 * (MH * 256); st[0] = *(const u32x4*)(gk_); st[1] = *(const u32x4*)(gk_ + (size_t)32 * (MH * 256)); \
        st[2] = *(const u32x4*)(gr + (size_t)(t) * 64 * 64); st[3] = *(const u32x4*)(gk_ + 128); st[4] = *(const u32x4*)(gk_ + (size_t)32 * (MH * 256) + 128); } while (0)
#define MLA_COMMIT(buf) do { LAS unsigned char* b_ = lds + (buf) * BUF_BYTES; *(LAS u32x4*)(b_ + dk0) = st[0]; *(LAS u32x4*)(b_ + dk0 + 32 * KRS) = st[1]; *(LAS u32x4*)(b_ + dr0) = st[2]; \
        *(LAS u32x4*)(b_ + dv0) = st[3]; *(LAS u32x4*)(b_ + dv0 + 32 * VRS) = st[4]; } while (0)
    const unsigned ka = r32 * KRS + hi * 16;
    const unsigned va = KT_BYTES + (4 * hi + ((lane & 15) >> 2)) * VRS + (16 * ((lane >> 4) & 1) + 4 * (lane & 3)) * 2;
    float m = -1e30f, l = 0.f;
    f32x16 O[4];
#pragma unroll
    for (int d = 0; d < 4; ++d)
#pragma unroll
        for (int r = 0; r < 16; ++r) O[d][r] = 0.f;
    const float c = 0.072168783648703220564f * 1.4426950408889634f;
    MLA_ISSUE(0); MLA_COMMIT(0); if (NT > 1) MLA_ISSUE(1);
    __syncthreads();
    for (int t = 0; t < NT; ++t) {
        const int buf = t & 1;
        if (t + 1 < NT) MLA_COMMIT(buf ^ 1);
        if (t + 2 < NT) MLA_ISSUE(t + 2);
        if (t < my_nt) {
            LAS unsigned char* kb = lds + buf * BUF_BYTES;
            f32x16 s0, s1;
#pragma unroll
            for (int r = 0; r < 16; ++r) { s0[r] = 0.f; s1[r] = 0.f; }
#pragma unroll
            for (int ks = 0; ks < 12; ++ks) {
                const bf16x8 a0 = *(const LAS bf16x8*)(kb + ka + ks * 32), a1 = *(const LAS bf16x8*)(kb + ka + 32 * KRS + ks * 32);
                s0 = __builtin_amdgcn_mfma_f32_32x32x16_bf16(a0, qf[ks], s0, 0, 0, 0);
                s1 = __builtin_amdgcn_mfma_f32_32x32x16_bf16(a1, qf[ks], s1, 0, 0, 0);
            }
            float mx = fmaxf(s0[0], s1[0]);
#pragma unroll
            for (int r = 1; r < 16; ++r) mx = fmaxf(mx, fmaxf(s0[r], s1[r]));
            mx = half_max(mx);
            const float mn = fmaxf(m, mx * c), alpha = __builtin_amdgcn_exp2f(m - mn); m = mn;
            float ps = 0.f;
#pragma unroll
            for (int r = 0; r < 16; ++r) { s0[r] = __builtin_amdgcn_exp2f(s0[r] * c - mn); s1[r] = __builtin_amdgcn_exp2f(s1[r] * c - mn); ps += s0[r] + s1[r]; }
            l = l * alpha + ps;
#pragma unroll
            for (int d = 0; d < 4; ++d)
#pragma unroll
                for (int r = 0; r < 16; ++r) O[d][r] *= alpha;
            u32x4 pf[4];
#pragma unroll
            for (int s = 0; s < 2; ++s) {
                pf[s] = (u32x4){cvtpk(s0[8 * s], s0[8 * s + 1]), cvtpk(s0[8 * s + 2], s0[8 * s + 3]), cvtpk(s0[8 * s + 4], s0[8 * s + 5]), cvtpk(s0[8 * s + 6], s0[8 * s + 7])};
                pf[2 + s] = (u32x4){cvtpk(s1[8 * s], s1[8 * s + 1]), cvtpk(s1[8 * s + 2], s1[8 * s + 3]), cvtpk(s1[8 * s + 4], s1[8 * s + 5]), cvtpk(s1[8 * s + 6], s1[8 * s + 7])};
            }
#pragma unroll
            for (int d = 0; d < 4; ++d)
#pragma unroll
                for (int f = 0; f < 4; ++f) {
                    const s16x4 lo = __builtin_bit_cast(s16x4, __builtin_amdgcn_ds_read_tr16_b64_v4i16((LAS s16x4*)(kb + va + (16 * f) * VRS + d * 64)));
                    const s16x4 hh = __builtin_bit_cast(s16x4, __builtin_amdgcn_ds_read_tr16_b64_v4i16((LAS s16x4*)(kb + va + (16 * f + 8) * VRS + d * 64)));
                    const bf16x8 vt = (bf16x8){lo[0], lo[1], lo[2], lo[3], hh[0], hh[1], hh[2], hh[3]};
                    O[d] = __builtin_amdgcn_mfma_f32_32x32x16_bf16(vt, __builtin_bit_cast(bf16x8, pf[f]), O[d], 0, 0, 0);
                }
        }
        __syncthreads();
    }
#undef MLA_ISSUE
#undef MLA_COMMIT
    l = half_sum(l);
    const float inv = 1.f / l;
    bf16_t* op = o + (row0 + q0 + wave * 32 + r32) * (MH * MV) + h * MV + 4 * hi;
#pragma unroll
    for (int d = 0; d < 4; ++d)
#pragma unroll
        for (int g = 0; g < 4; ++g) { u32x2 w; w.x = cvtpk(O[d][4 * g] * inv, O[d][4 * g + 1] * inv); w.y = cvtpk(O[d][4 * g + 2] * inv, O[d][4 * g + 3] * inv); *(u32x2*)(op + 32 * d + 8 * g) = w; }
}
__device__ __forceinline__ void attn_phase(LAS unsigned char* lds, const bf16_t* q, const bf16_t* kv, const bf16_t* kr, bf16_t* o, int bid, int nblk, int tid) {
    for (int u = bid; u < NB * MH * 4; u += nblk) {
        const int bh = u >> 2, s = u & 3;
        attn_unit(lds, q, kv, kr, o, bh / MH, bh % MH, s, tid);
        attn_unit(lds, q, kv, kr, o, bh / MH, bh % MH, 7 - s, tid);
    }
}
}

namespace gla {
typedef short bf16x8 __attribute__((ext_vector_type(8)));
typedef float f32x4v __attribute__((ext_vector_type(4)));
__device__ __forceinline__ void l_units(LAS unsigned char* lds, const bf16_t* __restrict__ xb, const bf16_t* __restrict__ wlr, const float* __restrict__ wgu, const float* __restrict__ bg, float* __restrict__ L, float* __restrict__ DEC, int bid, int nblk, int tid) {
    const int lane = tid & 63, wave = __builtin_amdgcn_readfirstlane(tid >> 6), fr = lane & 15, fq = lane >> 4;
    LAS float* part = (LAS float*)lds;
    LAS float* G = (LAS float*)(lds + 32768);
    for (int cn = bid; cn < M / CH; cn += nblk) {
        const size_t m0 = (size_t)cn * CH;
        f32x4v acc[4];
#pragma unroll
        for (int rt = 0; rt < 4; ++rt) acc[rt] = (f32x4v){0.f, 0.f, 0.f, 0.f};
#pragma unroll
        for (int ks = 0; ks < 4; ++ks) {
            const int k0 = wave * 128 + ks * 32 + fq * 8;
            const bf16x8 bfrag = *(const bf16x8*)(wlr + (size_t)fr * D + k0);
#pragma unroll
            for (int rt = 0; rt < 4; ++rt) { const bf16x8 afrag = *(const bf16x8*)(xb + (m0 + rt * 16 + fr) * D + k0); acc[rt] = __builtin_amdgcn_mfma_f32_16x16x32_bf16(afrag, bfrag, acc[rt], 0, 0, 0); }
        }
#pragma unroll
        for (int rt = 0; rt < 4; ++rt)
#pragma unroll
            for (int e = 0; e < 4; ++e) part[(wave * 64 + rt * 16 + fq * 4 + e) * 16 + fr] = acc[rt][e];
        __syncthreads();
#pragma unroll
        for (int i = 0; i < 2; ++i) { const int o = tid + 512 * i; float s = 0.f;
#pragma unroll
            for (int w = 0; w < 8; ++w) s += part[w * 1024 + o];
            G[o] = s; }
        __syncthreads();
        const int ch = tid; float w[GRANK];
#pragma unroll
        for (int r = 0; r < GRANK; ++r) w[r] = wgu[r * GHK + ch];
        const float bias = bg[ch]; float run = 0.f;
        for (int t = 0; t < CH; ++t) {
            float z = bias;
#pragma unroll
            for (int r4 = 0; r4 < 4; ++r4) { const f32x4v g = *(const LAS f32x4v*)(G + t * 16 + r4 * 4); z += g[0] * w[4 * r4] + g[1] * w[4 * r4 + 1] + g[2] * w[4 * r4 + 2] + g[3] * w[4 * r4 + 3]; }
            run += log_sigmoid(z) * (1.f / 16.f);
            L[(m0 + t) * GHK + ch] = run;
        }
        DEC[(size_t)cn * GHK + ch] = expf(run);
        __syncthreads();
    }
}
}

namespace gla {
typedef short s16x4 __attribute__((ext_vector_type(4)));
typedef float f32x16 __attribute__((ext_vector_type(16)));
typedef unsigned u32x4 __attribute__((ext_vector_type(4)));
typedef unsigned u32x2 __attribute__((ext_vector_type(2)));
__device__ __forceinline__ unsigned cvtpk(float lo, float hi) { typedef float f2 __attribute__((ext_vector_type(2))); typedef __bf16 b2 __attribute__((ext_vector_type(2))); f2 v = {lo, hi}; b2 b = __builtin_convertvector(v, b2); return __builtin_bit_cast(unsigned, b); }
__device__ __forceinline__ float half_sum(float v) { auto rr = __builtin_amdgcn_permlane32_swap(__float_as_uint(v), __float_as_uint(v), false, false); return __uint_as_float(rr[0]) + __uint_as_float(rr[1]); }
__device__ __forceinline__ bf16x8 trfrag(LAS unsigned char* p0, LAS unsigned char* p1) {
    const s16x4 lo = __builtin_bit_cast(s16x4, __builtin_amdgcn_ds_read_tr16_b64_v4i16((LAS s16x4*)p0)), hh = __builtin_bit_cast(s16x4, __builtin_amdgcn_ds_read_tr16_b64_v4i16((LAS s16x4*)p1));
    return (bf16x8){lo[0], lo[1], lo[2], lo[3], hh[0], hh[1], hh[2], hh[3]};
}
constexpr int QRS = 272, VRS2 = 576;
constexpr int QT_BYTES = 64 * QRS, OFF_QP = 0, OFF_QN = QT_BYTES, OFF_KP = 2 * QT_BYTES, OFF_KN = 3 * QT_BYTES, OFF_V = 4 * QT_BYTES, OFF_SSQ = OFF_V + 64 * VRS2;
__device__ __forceinline__ void out_phase(LAS unsigned char* lds, const bf16_t* __restrict__ proj, const bf16_t* __restrict__ ST, const float* __restrict__ ng, bf16_t* __restrict__ og, int bid, int nblk, int tid) {
    const int lane = tid & 63, wave = __builtin_amdgcn_readfirstlane(tid >> 6), r32 = lane & 31, hi = lane >> 5;
    LAS float* SSQ = (LAS float*)(lds + OFF_SSQ);
    const unsigned qa = r32 * QRS + hi * 16;
    const unsigned va = OFF_V + (4 * hi + ((lane & 15) >> 2)) * VRS2 + (wave * 32 + 16 * ((lane >> 4) & 1) + 4 * (lane & 3)) * 2;
    for (int u = bid; u < NB * GH * NCH; u += nblk) {
        const int n = u % NCH, h = (u / NCH) % GH, b = u / (NCH * GH);
        const size_t m0 = (size_t)b * S + (size_t)n * CH;
        { u32x4 st[12];
#pragma unroll
          for (int i = 0; i < 8; ++i) { const int idx = tid + 512 * i, tile = idx >> 10, row = (idx >> 4) & 63, ch = idx & 15; st[i] = *(const u32x4*)(proj + (m0 + row) * 4096 + tile * 512 + h * GDK + ch * 8); }
#pragma unroll
          for (int i = 0; i < 4; ++i) { const int idx = tid + 512 * i, row = idx >> 5, ch = idx & 31; st[8 + i] = *(const u32x4*)(proj + (m0 + row) * 4096 + 2048 + h * GDV + ch * 8); }
#pragma unroll
          for (int i = 0; i < 8; ++i) { const int idx = tid + 512 * i, tile = idx >> 10, row = (idx >> 4) & 63, ch = idx & 15; *(LAS u32x4*)(lds + tile * QT_BYTES + row * QRS + ch * 16) = st[i]; }
#pragma unroll
          for (int i = 0; i < 4; ++i) { const int idx = tid + 512 * i, row = idx >> 5, ch = idx & 31; *(LAS u32x4*)(lds + OFF_V + row * VRS2 + ch * 16) = st[8 + i]; } }
        bf16x8 sf[8];
        { const bf16_t* sp = ST + ((size_t)u * GDV + wave * 32 + r32) * GDK + 8 * hi;
#pragma unroll
          for (int ks = 0; ks < 8; ++ks) sf[ks] = *(const bf16x8*)(sp + 16 * ks); }
        __syncthreads();
        f32x16 O[2];
#pragma unroll
        for (int tt = 0; tt < 2; ++tt) {
            bf16x8 qp[8], qn[8];
#pragma unroll
            for (int ks = 0; ks < 8; ++ks) { qp[ks] = *(const LAS bf16x8*)(lds + OFF_QP + tt * 32 * QRS + qa + ks * 32); qn[ks] = *(const LAS bf16x8*)(lds + OFF_QN + tt * 32 * QRS + qa + ks * 32); }
            u32x4 pf[4];
#pragma unroll
            for (int st_ = 0; st_ < 2; ++st_) {
                f32x16 p1, p2;
#pragma unroll
                for (int r = 0; r < 16; ++r) { p1[r] = 0.f; p2[r] = 0.f; }
                if (st_ <= tt) {
#pragma unroll
                    for (int ks = 0; ks < 8; ++ks) p1 = __builtin_amdgcn_mfma_f32_32x32x16_bf16(*(const LAS bf16x8*)(lds + OFF_KN + st_ * 32 * QRS + qa + ks * 32), qp[ks], p1, 0, 0, 0);
                }
                if (st_ >= tt) {
#pragma unroll
                    for (int ks = 0; ks < 8; ++ks) p2 = __builtin_amdgcn_mfma_f32_32x32x16_bf16(*(const LAS bf16x8*)(lds + OFF_KP + st_ * 32 * QRS + qa + ks * 32), qn[ks], p2, 0, 0, 0);
                }
                if (st_ == tt) {
#pragma unroll
                    for (int r = 0; r < 16; ++r) { const int srow = (r & 3) + 8 * (r >> 2) + 4 * hi; p1[r] = (r32 >= srow) ? p1[r] : p2[r]; }
                } else if (st_ > tt) p1 = p2;
#pragma unroll
                for (int s2 = 0; s2 < 2; ++s2) pf[st_ * 2 + s2] = (u32x4){cvtpk(p1[8 * s2], p1[8 * s2 + 1]), cvtpk(p1[8 * s2 + 2], p1[8 * s2 + 3]), cvtpk(p1[8 * s2 + 4], p1[8 * s2 + 5]), cvtpk(p1[8 * s2 + 6], p1[8 * s2 + 7])};
            }
            f32x16 o;
#pragma unroll
            for (int r = 0; r < 16; ++r) o[r] = 0.f;
#pragma unroll
            for (int f = 0; f < 4; ++f) o = __builtin_amdgcn_mfma_f32_32x32x16_bf16(trfrag(lds + va + (16 * f) * VRS2, lds + va + (16 * f + 8) * VRS2), __builtin_bit_cast(bf16x8, pf[f]), o, 0, 0, 0);
#pragma unroll
            for (int ks = 0; ks < 8; ++ks) o = __builtin_amdgcn_mfma_f32_32x32x16_bf16(sf[ks], qp[ks], o, 0, 0, 0);
            O[tt] = o;
            float ss = 0.f;
#pragma unroll
            for (int r = 0; r < 16; ++r) ss += o[r] * o[r];
            ss = half_sum(ss);
            if (hi == 0) SSQ[wave * 64 + tt * 32 + r32] = ss;
        }
        __syncthreads();
#pragma unroll
        for (int tt = 0; tt < 2; ++tt) {
            float tot = 0.f;
#pragma unroll
            for (int w = 0; w < 8; ++w) tot += SSQ[w * 64 + tt * 32 + r32];
            const float rstd = rsqrtf(tot * (1.f / GDV) + RMS_EPS);
            const size_t m = m0 + tt * 32 + r32;
#pragma unroll
            for (int g = 0; g < 4; ++g) { const int dv0 = wave * 32 + 8 * g + 4 * hi;
                const u32x2 rw = *(const u32x2*)(proj + m * 4096 + 3072 + h * GDV + dv0); const f32x4v gg = *(const f32x4v*)(ng + dv0);
                const float r0 = __uint_as_float(rw.x << 16), r1 = __uint_as_float(rw.x & 0xffff0000u), r2 = __uint_as_float(rw.y << 16), r3 = __uint_as_float(rw.y & 0xffff0000u);
                const float o0 = O[tt][4 * g] * rstd * gg[0] * (r0 / (1.f + __expf(-r0))), o1 = O[tt][4 * g + 1] * rstd * gg[1] * (r1 / (1.f + __expf(-r1)));
                const float o2 = O[tt][4 * g + 2] * rstd * gg[2] * (r2 / (1.f + __expf(-r2))), o3 = O[tt][4 * g + 3] * rstd * gg[3] * (r3 / (1.f + __expf(-r3)));
                u32x2 w; w.x = cvtpk(o0, o1); w.y = cvtpk(o2, o3); *(u32x2*)(og + m * GHV + h * GDV + dv0) = w; }
        }
        __syncthreads();
    }
}
}

namespace gla {
constexpr int SK_RS = 320, SV_RS = 64, SK_BYTES = 64 * SK_RS, SBUF = SK_BYTES + 64 * SV_RS;
__device__ __forceinline__ void state_phase(LAS unsigned char* lds, const bf16_t* __restrict__ proj, const float* __restrict__ DEC, bf16_t* __restrict__ ST, int bid, int nblk, int tid) {
    const int lane = tid & 63, wave = __builtin_amdgcn_readfirstlane(tid >> 6), r32 = lane & 31, hi = lane >> 5, i16 = lane & 15, g1 = (lane >> 4) & 1;
    for (int u = bid; u < NB * GH * 8; u += nblk) {
        const int dvs = u & 7, h = (u >> 3) & 3, b = u >> 5;
        const size_t mb = (size_t)b * S;
        const int krow = tid >> 4, kch = tid & 15, vrow = (tid >> 2) & 63, vch = tid & 3;
        const bf16_t* gk = proj + (mb + krow) * 4096 + 1536 + h * GDK + kch * 8;
        const bf16_t* gv = proj + (mb + vrow) * 4096 + 2048 + h * GDV + dvs * 32 + vch * 8;
        u32x4 st[3];
#define ST_ISSUE(n) do { st[0] = *(const u32x4*)(gk + (size_t)(n) * 64 * 4096); st[1] = *(const u32x4*)(gk + ((size_t)(n) * 64 + 32) * 4096); if (wave < 4) st[2] = *(const u32x4*)(gv + (size_t)(n) * 64 * 4096); } while (0)
#define ST_COMMIT(buf) do { LAS unsigned char* b_ = lds + (buf) * SBUF; *(LAS u32x4*)(b_ + krow * SK_RS + kch * 16) = st[0]; *(LAS u32x4*)(b_ + (krow + 32) * SK_RS + kch * 16) = st[1]; \
        if (wave < 4) *(LAS u32x4*)(b_ + SK_BYTES + vrow * SV_RS + vch * 16) = st[2]; } while (0)
        const unsigned aoff = SK_BYTES + (8 * hi + (i16 >> 2)) * SV_RS + (16 * g1 + 4 * (i16 & 3)) * 2;
        const unsigned boff = (8 * hi + (i16 >> 2)) * SK_RS + ((wave & 3) * 32 + 16 * g1 + 4 * (i16 & 3)) * 2;
        const float* dp = DEC + (size_t)b * NCH * GHK + h * GDK + (wave & 3) * 32 + r32;
        bf16_t* sp = ST + ((size_t)(b * GH + h) * NCH * GDV + dvs * 32 + 4 * hi) * GDK + (wave & 3) * 32 + r32;
        f32x16 acc;
#pragma unroll
        for (int r = 0; r < 16; ++r) acc[r] = 0.f;
        float dnext = dp[0];
        ST_ISSUE(0); ST_COMMIT(0); ST_ISSUE(1);
        __syncthreads();
        for (int n = 0; n < NCH; ++n) {
            const int buf = n & 1;
            if (n + 1 < NCH) ST_COMMIT(buf ^ 1);
            if (n + 2 < NCH) ST_ISSUE(n + 2);
            if (wave < 4) {
                const float dcur = dnext; if (n + 1 < NCH) dnext = dp[(size_t)(n + 1) * GHK];
                bf16_t* o = sp + (size_t)n * GDV * GDK;
#pragma unroll
                for (int r = 0; r < 16; ++r) o[(size_t)((r & 3) + 8 * (r >> 2)) * GDK] = (bf16_t)f2bf(acc[r]);
                LAS unsigned char* bb = lds + buf * SBUF;
#pragma unroll
                for (int ks = 0; ks < 4; ++ks) {
                    const bf16x8 af = trfrag(bb + aoff + (16 * ks) * SV_RS, bb + aoff + (16 * ks + 4) * SV_RS);
                    const bf16x8 bf = trfrag(bb + boff + (16 * ks) * SK_RS, bb + boff + (16 * ks + 4) * SK_RS);
                    acc = __builtin_amdgcn_mfma_f32_32x32x16_bf16(af, bf, acc, 0, 0, 0);
                }
#pragma unroll
                for (int r = 0; r < 16; ++r) acc[r] *= dcur;
            }
            __syncthreads();
        }
#undef ST_ISSUE
#undef ST_COMMIT
    }
}
}

#define RLX_AGENT __ATOMIC_RELAXED, __HIP_MEMORY_SCOPE_AGENT
#define XB_TMO      128
#define XB_XCNT(j)  (256  + 64 * (j))
#define XB_XSUB(j)  (1280 + 64 * (j))
#define XB_XGEN(j)  (2304 + 64 * (j))
#define XB_TOP      3328
#define XB_TOPGEN   3392
#define XCD_BAR_WORDS 3456
#define XB_SPIN_CAP (1u << 18)

__device__ __forceinline__ unsigned xb_ld(unsigned* p)              { return __hip_atomic_load(p, __ATOMIC_RELAXED, __HIP_MEMORY_SCOPE_AGENT); }
__device__ __forceinline__ unsigned xb_add(unsigned* p, unsigned v) { return __hip_atomic_fetch_add(p, v, __ATOMIC_RELAXED, __HIP_MEMORY_SCOPE_AGENT); }
__device__ __forceinline__ unsigned xb_xcc_id() { return (unsigned)__builtin_amdgcn_s_getreg((3 << 11) | 20) & 0xFu; }
#define XB_SPIN(cond, bar) do { unsigned _sp = 0; while (cond) { __builtin_amdgcn_s_sleep(1); \
    if ((++_sp & 255u) == 0u) { if (xb_ld(&(bar)[XB_TMO])) break; if (_sp > XB_SPIN_CAP) { atomicAdd(&(bar)[XB_TMO], 1u); break; } } } } while (0)

struct XcdBarrier {
    unsigned* bar; unsigned x;
    volatile LAS unsigned* st;
};

__device__ __forceinline__ XcdBarrier xcd_barrier_post(unsigned* bar, volatile LAS unsigned* st) {
    XcdBarrier b; b.bar = bar; b.x = xb_xcc_id(); b.st = st;
    if (threadIdx.x == 0) (void)xb_add(&bar[XB_XCNT(b.x)], 1u);
    return b;
}
__device__ __forceinline__ void xcd_barrier_complete(unsigned* bar, unsigned x, unsigned& nloc, unsigned& nx) {
    const unsigned G = gridDim.x * gridDim.y * gridDim.z;
    unsigned sum, cnt, mine, sp = 0u;
    for (;;) {
        sum = 0u; cnt = 0u; mine = 0u;
#pragma unroll
        for (unsigned j = 0; j < 16; ++j) { const unsigned c = xb_ld(&bar[XB_XCNT(j)]); sum += c; cnt += (c > 0u) ? 1u : 0u; mine = (j == x) ? c : mine; }
        if (sum == G) break;
        __builtin_amdgcn_s_sleep(1);
        if ((++sp & 255u) == 0u) { if (xb_ld(&bar[XB_TMO])) break; if (sp > XB_SPIN_CAP) { atomicAdd(&bar[XB_TMO], 1u); break; } }
    }
    nloc = mine > 0u ? mine : 1u; nx = cnt > 0u ? cnt : 1u;
}

__device__ __forceinline__ void xcd_barrier(const XcdBarrier& b) {
    asm volatile("s_waitcnt vmcnt(0)" ::: "memory");
    __syncthreads();
    if (threadIdx.x == 0) {
        unsigned* bar = b.bar;
        __builtin_amdgcn_s_waitcnt(0);
        unsigned nloc = b.st[0], nx = b.st[1];
        if (nloc == 0u) { xcd_barrier_complete(bar, b.x, nloc, nx); b.st[0] = nloc; b.st[1] = nx; }
        const unsigned old = xb_add(&bar[XB_XSUB(b.x)], 1u);
        const unsigned gen = old / nloc;
        if (old + 1u == (gen + 1u) * nloc) {
            __builtin_amdgcn_fence(__ATOMIC_RELEASE, "agent");
            asm volatile("s_waitcnt vmcnt(0)" ::: "memory");
            const unsigned og = xb_add(&bar[XB_TOP], 1u);
            const unsigned tg = og / nx;
            if (og + 1u == (tg + 1u) * nx) xb_add(&bar[XB_TOPGEN], 1u);
            else XB_SPIN(xb_ld(&bar[XB_TOPGEN]) == tg, bar);
            __builtin_amdgcn_fence(__ATOMIC_ACQUIRE, "agent");
            xb_add(&bar[XB_XGEN(b.x)], 1u);
            asm volatile("s_waitcnt vmcnt(0)" ::: "memory");
        } else {
            XB_SPIN(xb_ld(&bar[XB_XGEN(b.x)]) == gen, bar);
            __builtin_amdgcn_fence(__ATOMIC_ACQUIRE, "agent");
            asm volatile("s_waitcnt vmcnt(0)" ::: "memory");
        }
    }
    __syncthreads();
}

typedef float f32x4 __attribute__((ext_vector_type(4)));
typedef unsigned v4u __attribute__((ext_vector_type(4)));
typedef unsigned v2u __attribute__((ext_vector_type(2)));
constexpr int NWAVES = 8, NTHREADS = 512;
constexpr int LDS_BYTES = 147456, MISC_OFF = 131072 + 320, CW_BAR = 4096;
constexpr size_t MiB = 1u << 20;
constexpr size_t WS_CTL = 0, WS_CS = 1 * MiB, WS_WSET0 = 5 * MiB, WS_WSET1 = 32 * MiB, WS_B0 = 59 * MiB, WS_B1 = 91 * MiB, WS_BIG = 123 * MiB, WS_AUX = 251 * MiB, WS_PP = 299 * MiB, WS_GLR = 331 * MiB, WS_END = 332 * MiB;
constexpr size_t WO_IN = 0, WO_UQ = 786432, WO_UKV = 1179648, WO_OUT = 3145728, WO_W1 = 4194304, WO_W2 = 8388608, WO_G = 12582912, WO_P = 13631488, WO_LR = 13893632, WO_END = 13910016;
static_assert(WO_END * 2 <= 27 * MiB, "weight set fits its 27 MiB");

struct Args { const void* in[23]; float* out; unsigned char* ws; };

struct Ctx { int tid, lane, wave, gw, ngw, bid, nblk; LAS unsigned char* lds; };

__device__ __forceinline__ void tr_matrix(const Ctx& c, const float* W, int ldw, int K, int N, bf16_t* WT) {
    LAS float* scr = (LAS float*)(c.lds + c.wave * 16384);
    const int nblk = N / 32, nitems = (K / 64) * nblk, lane = c.lane;
    for (int it = c.gw; it < nitems; it += c.ngw) {
        const int kb = it / nblk, nb = it % nblk, k0 = 64 * kb, n0 = 32 * nb;
#pragma unroll 8
        for (int i = 0; i < 32; ++i) { const int kk = 2 * i + (lane >> 5); scr[kk * 33 + (lane & 31)] = W[(size_t)(k0 + kk) * ldw + n0 + (lane & 31)]; }
        asm volatile("s_waitcnt lgkmcnt(0)" ::: "memory");
        const int ch = lane & 7;
#pragma unroll
        for (int j = 0; j < 4; ++j) { const int n = (lane >> 3) + 8 * j; const LAS float* s = scr + (8 * ch) * 33 + n;
            v4u o; o.x = pk2(s[0 * 33], s[1 * 33]); o.y = pk2(s[2 * 33], s[3 * 33]); o.z = pk2(s[4 * 33], s[5 * 33]); o.w = pk2(s[6 * 33], s[7 * 33]);
            *(v4u*)(WT + (size_t)(n0 + n) * K + k0 + 8 * ch) = o; }
        asm volatile("s_waitcnt lgkmcnt(0)" ::: "memory");
    }
}
__device__ __forceinline__ void convert_weights(const Ctx& c, const Args& a, int i, bf16_t* WS) {
    const int j = i / 3, kind = i % 3;
    if (kind == 0) {
        tr_matrix(c, (const float*)a.in[3] + (size_t)j * D * GLA_IN, GLA_IN, D, 3072, WS + WO_IN);
        tr_matrix(c, (const float*)a.in[7] + (size_t)j * GHV * D, D, GHV, D, WS + WO_OUT);
        { const float* Wl = (const float*)a.in[3] + (size_t)j * D * GLA_IN + 3072;
          for (int e = c.bid * NTHREADS + c.tid; e < D * GRANK; e += c.nblk * NTHREADS) { const int k = e >> 4, n = e & 15; WS[WO_LR + (size_t)n * D + k] = (bf16_t)f2bf(Wl[(size_t)k * GLA_IN + n]); } }
    } else if (kind == 1) {
        tr_matrix(c, (const float*)a.in[8] + (size_t)j * D * MLA_IN, MLA_IN, D, MLA_IN, WS + WO_IN);
        { unsigned zz = 0u; asm volatile("" : "+v"(zz));
          for (size_t e = (size_t)c.bid * NTHREADS + c.tid; e < (size_t)(MLA_INP - MLA_IN) * D / 8; e += (size_t)c.nblk * NTHREADS) *((v4u*)(WS + WO_IN + (size_t)MLA_IN * D) + e) = (v4u){zz, zz, zz, zz}; }
        tr_matrix(c, (const float*)a.in[11] + (size_t)j * 256 * 1536, 1536, 256, 1536, WS + WO_UQ);
        tr_matrix(c, (const float*)a.in[12] + (size_t)j * 256 * 2048, 2048, 256, 2048, WS + WO_UKV);
        tr_matrix(c, (const float*)a.in[13] + (size_t)j * D * D, D, D, D, WS + WO_OUT);
    } else {
        tr_matrix(c, (const float*)a.in[14] + (size_t)j * D * 3 * D, 3 * D, D, 3 * D, WS + WO_IN);
        tr_matrix(c, (const float*)a.in[16] + (size_t)j * D * D, D, D, D, WS + WO_OUT);
    }
    tr_matrix(c, (const float*)a.in[19] + (size_t)i * D * FF, FF, D, FF, WS + WO_W1);
    tr_matrix(c, (const float*)a.in[20] + (size_t)i * FF * D, D, FF, D, WS + WO_W2);
    tr_matrix(c, (const float*)a.in[21] + (size_t)i * D * D, D, D, D, WS + WO_G);
    tr_matrix(c, (const float*)a.in[22] + (size_t)i * PLE * D, D, PLE, D, WS + WO_P);
}
__device__ __forceinline__ void cvt_rows(const Ctx& c, const float* src, bf16_t* dst, size_t n) {
    for (size_t e = (size_t)c.bid * NTHREADS + c.tid; e < n / 4; e += (size_t)c.nblk * NTHREADS) { const f32x4 v = ((const f32x4*)src)[e]; v2u o; o.x = pk2(v.x, v.y); o.y = pk2(v.z, v.w); ((v2u*)dst)[e] = o; }
}
__device__ __forceinline__ void ln_pass(const Ctx& c, float* X, const float* g, const float* b, bf16_t* xb) {
    for (int m = c.gw; m < M; m += c.ngw) {
        f32x4* xr = (f32x4*)(X + (size_t)m * D) + c.lane;
        f32x4 v[4]; float s = 0.f;
#pragma unroll
        for (int j = 0; j < 4; ++j) { v[j] = xr[64 * j]; s += (v[j].x + v[j].y) + (v[j].z + v[j].w); }
        const float mean = wave_sum(s) * (1.f / D); float s2 = 0.f;
#pragma unroll
        for (int j = 0; j < 4; ++j) { v[j] = v[j] - mean; s2 += (v[j].x * v[j].x + v[j].y * v[j].y) + (v[j].z * v[j].z + v[j].w * v[j].w); }
        const float rstd = 1.f / sqrtf(wave_sum(s2) * (1.f / D) + LN_EPS);
        v2u* o8 = (v2u*)(xb + (size_t)m * D) + c.lane;
#pragma unroll
        for (int j = 0; j < 4; ++j) { const f32x4 gg = ((const f32x4*)g)[c.lane + 64 * j], bb = ((const f32x4*)b)[c.lane + 64 * j]; const f32x4 o = v[j] * rstd * gg + bb;
            xr[64 * j] = o; v2u w; w.x = pk2(o.x, o.y); w.y = pk2(o.z, o.w); o8[64 * j] = w; }
    }
}


enum { T_NOP = 0, T_PROLOGUE, T_GEMM_BF16, T_GEMM_RELU2, T_GEMM_RES, T_GEMM_PLE, T_GLA_LUNIT, T_GLA_STATE, T_GLA_OUT, T_GEMM_GLA, T_MLA_PREP, T_MLA_QROPE, T_MLA_ATTN, T_CONVMIX, T_LN, T_PCVT, T_WCVT };
struct Op { int type, sync, n0, n1; const void *a0, *a1, *a2, *a3, *a4; void *o0, *o1, *o2; };

__device__ __forceinline__ int n_mixer_steps(int kind) { return kind == 2 ? 2 : (kind == 1 ? 6 : 4); }
__device__ __forceinline__ void decode(const Args& a, int i, int s, Op& op) {
    unsigned char* ws = a.ws;
    const int j = i / 3, kind = i % 3, nm = n_mixer_steps(kind);
    bf16_t* W = (bf16_t*)(ws + ((i & 1) ? WS_WSET1 : WS_WSET0));
    bf16_t* B0 = (bf16_t*)(ws + WS_B0); bf16_t* B1 = (bf16_t*)(ws + WS_B1); bf16_t* BIG = (bf16_t*)(ws + WS_BIG); bf16_t* AUX = (bf16_t*)(ws + WS_AUX); bf16_t* PP = (bf16_t*)(ws + WS_PP);
    float* XR = a.out; float* CS = (float*)(ws + WS_CS); float* GLR = (float*)(ws + WS_GLR);
    op.type = T_NOP; op.sync = 1; op.n0 = 0; op.n1 = 0; op.a0 = op.a1 = op.a2 = op.a3 = op.a4 = nullptr; op.o0 = op.o1 = op.o2 = nullptr;
    if (s < nm) {
        if (kind == 0) {
            bf16_t* PROJ = BIG; float* L = (float*)(ws + WS_B1); bf16_t* ST = AUX; float* DEC = GLR;
            switch (s) {
            case 0: op.type = T_GLA_LUNIT; op.a0 = B0; op.a1 = W + WO_LR; op.a2 = (const float*)a.in[4] + (size_t)j * GRANK * GHK; op.a3 = (const float*)a.in[5] + (size_t)j * GHK; op.o0 = L; op.o1 = DEC; break;
            case 1: op.type = T_GEMM_GLA; op.a0 = B0; op.a1 = W + WO_IN; op.n0 = 3072; op.n1 = D; op.o0 = PROJ; op.a2 = L; break;
            case 2: op.type = T_GLA_STATE; op.a0 = PROJ; op.a1 = DEC; op.o0 = ST; break;
            default: op.type = T_GLA_OUT; op.a0 = PROJ; op.a1 = ST; op.a2 = (const float*)a.in[6] + (size_t)j * GDV; op.o0 = B1; break;
            }
        } else if (kind == 1) {
            bf16_t* Cb = AUX; bf16_t* cqn = AUX + (size_t)12 * MiB; bf16_t* ckvn = AUX + (size_t)16 * MiB; bf16_t* kr = AUX + (size_t)20 * MiB;
            bf16_t* q = BIG; bf16_t* kv = BIG + (size_t)24 * MiB;
            switch (s) {
            case 0: op.type = T_GEMM_BF16; op.a0 = B0; op.a1 = W + WO_IN; op.n0 = MLA_INP; op.n1 = D; op.o0 = Cb; break;
            case 1: op.type = T_MLA_PREP; op.a0 = Cb; op.a1 = (const float*)a.in[9] + j * 256; op.a2 = (const float*)a.in[10] + j * 256; op.a3 = CS; op.o0 = cqn; op.o1 = ckvn; op.o2 = kr; break;
            case 2: op.type = T_GEMM_BF16; op.sync = 0; op.a0 = cqn; op.a1 = W + WO_UQ; op.n0 = 1536; op.n1 = 256; op.o0 = q; break;
            case 3: op.type = T_GEMM_BF16; op.a0 = ckvn; op.a1 = W + WO_UKV; op.n0 = 2048; op.n1 = 256; op.o0 = kv; break;
            case 4: op.type = T_MLA_QROPE; op.a0 = CS; op.o0 = q; break;
            default: op.type = T_MLA_ATTN; op.a0 = q; op.a1 = kv; op.a2 = kr; op.o0 = B1; break;
            }
        } else {
            if (s == 0) { op.type = T_GEMM_BF16; op.a0 = B0; op.a1 = W + WO_IN; op.n0 = 3 * D; op.n1 = D; op.o0 = BIG; }
            else { op.type = T_CONVMIX; op.a0 = BIG; op.a1 = (const float*)a.in[15] + (size_t)j * 3 * D; op.o0 = B1; }
        }
    } else {
        switch (s - nm) {
        case 0: op.type = T_GEMM_RES; op.a0 = B1; op.a1 = W + WO_OUT; op.n0 = D; op.n1 = D; op.a2 = (i == 0) ? (const float*)a.in[0] : XR; op.o0 = XR; break;
        case 1: op.type = T_LN; op.sync = 0; op.a0 = (const float*)a.in[17] + (size_t)(2 * i) * D; op.a1 = (const float*)a.in[18] + (size_t)(2 * i) * D; op.o0 = XR; op.o1 = B0; break;
        case 2: op.type = T_PCVT; op.sync = 0; op.a0 = (const float*)a.in[1] + (size_t)i * M * PLE; op.o0 = AUX; break;
        case 3: op.type = (i + 1 < DEPTH) ? T_WCVT : T_NOP; op.n0 = i + 1; op.o0 = ws + (((i + 1) & 1) ? WS_WSET1 : WS_WSET0); break;
        case 4: op.type = T_GEMM_RELU2; op.sync = 0; op.a0 = B0; op.a1 = W + WO_W1; op.n0 = FF; op.n1 = D; op.o0 = BIG; break;
        case 5: op.type = T_GEMM_BF16; op.a0 = AUX; op.a1 = W + WO_P; op.n0 = D; op.n1 = PLE; op.o0 = PP; break;
        case 6: op.type = T_GEMM_RES; op.a0 = BIG; op.a1 = W + WO_W2; op.n0 = D; op.n1 = FF; op.a2 = XR; op.o0 = XR; break;
        case 7: op.type = T_LN; op.a0 = (const float*)a.in[17] + (size_t)(2 * i + 1) * D; op.a1 = (const float*)a.in[18] + (size_t)(2 * i + 1) * D; op.o0 = XR; op.o1 = B1; break;
        default: op.type = T_GEMM_PLE; op.sync = (i + 1 < DEPTH) ? 1 : 0; op.a0 = B1; op.a1 = W + WO_G; op.n0 = D; op.n1 = D; op.a2 = PP; op.o0 = XR; op.o1 = B0; break;
        }
    }
}

#define RUN_GEMM(EPI_T, ...) do { pg8::Gemm g_{(const bf16_t*)op.a0, (const bf16_t*)op.a1, M, op.n0, op.n1}; pg8::StaticOrder S_; S_.init(M, op.n0, c.nblk, c.bid); \
    EPI_T E_{__VA_ARGS__}; pg8::gemm_phase<EPI_T, pg8::StaticOrder, true, true>(c.lds, g_, S_, E_); } while (0)

__global__ void __launch_bounds__(NTHREADS, 2) mega_fwd(Args a) {
    extern __shared__ __attribute__((aligned(16))) unsigned char lds_raw[];
    cg::grid_group grid = cg::this_grid();
    { LAS unsigned* z = (LAS unsigned*)(lds_raw) + MISC_OFF / 4; if (threadIdx.x < 32) z[threadIdx.x] = 0u; }
    __syncthreads();
    (void)xcd_barrier_post((unsigned*)(a.ws + WS_CTL) + CW_BAR, (volatile LAS unsigned*)((LAS unsigned char*)lds_raw + MISC_OFF) + 8);
    bool first_sync = true;
    for (int i = -1; i < DEPTH; ++i) {
        const int ns = (i < 0) ? 1 : n_mixer_steps(i % 3) + 9;
        for (int s = 0; s < ns; ++s) {
            Ctx c; c.tid = tid_now(); c.bid = bid_now(); c.lane = c.tid & 63; c.wave = __builtin_amdgcn_readfirstlane(c.tid >> 6); c.nblk = nblk_now(); c.gw = c.bid * NWAVES + c.wave; c.ngw = c.nblk * NWAVES; c.lds = (LAS unsigned char*)lds_raw;
            Op op;
            if (i < 0) { op.type = T_PROLOGUE; op.sync = 1; op.n0 = op.n1 = 0; op.a0 = op.a1 = op.a2 = op.a3 = op.a4 = nullptr; op.o0 = op.o1 = op.o2 = nullptr; }
            else decode(a, i, s, op);
            switch (op.type) {
            case T_PROLOGUE: {
                const int* pos = (const int*)a.in[2]; float* CS = (float*)(a.ws + WS_CS);
                for (size_t e = (size_t)c.bid * NTHREADS + c.tid; e < (size_t)M * 32; e += (size_t)c.nblk * NTHREADS) {
                    const int jj = (int)(e & 31); const size_t m = e >> 5; const float ang = (float)pos[m] * inv_freq(jj);
                    float sn_, cs_; sincosf(ang, &sn_, &cs_); CS[m * 64 + jj] = cs_; CS[m * 64 + 32 + jj] = sn_;
                }
                cvt_rows(c, (const float*)a.in[0], (bf16_t*)(a.ws + WS_B0), (size_t)M * D);
                convert_weights(c, a, 0, (bf16_t*)(a.ws + WS_WSET0));
            } break;
            case T_GEMM_BF16: RUN_GEMM(pg8::EpiBf16<0>, (bf16_t*)op.o0, op.n0); break;
            case T_GEMM_RELU2: RUN_GEMM(pg8::EpiBf16<2>, (bf16_t*)op.o0, op.n0); break;
            case T_GEMM_RES: RUN_GEMM(pg8::EpiRes, (const float*)op.a2, (float*)op.o0, D, ALPHA); break;
            case T_GEMM_PLE: RUN_GEMM(pg8::EpiPle, (const float*)op.o0, (float*)op.o0, (const bf16_t*)op.a2, (bf16_t*)op.o1, D); break;
            case T_GLA_LUNIT: gla::l_units(c.lds, (const bf16_t*)op.a0, (const bf16_t*)op.a1, (const float*)op.a2, (const float*)op.a3, (float*)op.o0, (float*)op.o1, c.bid, c.nblk, c.tid); break;
            case T_GEMM_GLA: RUN_GEMM(pg8::EpiGla, (bf16_t*)op.o0, (const float*)op.a2); break;
            case T_GLA_STATE: gla::state_phase(c.lds, (const bf16_t*)op.a0, (const float*)op.a1, (bf16_t*)op.o0, c.bid, c.nblk, c.tid); break;
            case T_GLA_OUT: gla::out_phase(c.lds, (const bf16_t*)op.a0, (const bf16_t*)op.a1, (const float*)op.a2, (bf16_t*)op.o0, c.bid, c.nblk, c.tid); break;
            case T_MLA_PREP: mla_prep<bf16_t, bf16_t>((const bf16_t*)op.a0, MLA_INP, (const float*)op.a1, (const float*)op.a2, (const float*)op.a3, (bf16_t*)op.o0, (bf16_t*)op.o1, (bf16_t*)op.o2, M); break;
            case T_MLA_QROPE: mla_qrope<bf16_t>((bf16_t*)op.o0, (const float*)op.a0, M); break;
            case T_MLA_ATTN: mla::attn_phase(c.lds, (const bf16_t*)op.a0, (const bf16_t*)op.a1, (const bf16_t*)op.a2, (bf16_t*)op.o0, c.bid, c.nblk, c.tid); break;
            case T_CONVMIX: conv_mix<bf16_t, bf16_t>((const bf16_t*)op.a0, 3 * D, (const float*)op.a1, (bf16_t*)op.o0, M); break;
            case T_LN: ln_pass(c, (float*)op.o0, (const float*)op.a0, (const float*)op.a1, (bf16_t*)op.o1); break;
            case T_PCVT: cvt_rows(c, (const float*)op.a0, (bf16_t*)op.o0, (size_t)M * PLE); break;
            case T_WCVT: convert_weights(c, a, op.n0, (bf16_t*)op.o0); break;
            default: break;
            }
            if (op.sync) {
                if (first_sync) { grid.sync(); first_sync = false; }
                else { XcdBarrier bar; bar.bar = (unsigned*)(a.ws + WS_CTL) + CW_BAR; bar.x = xb_xcc_id(); bar.st = (volatile LAS unsigned*)((LAS unsigned char*)lds_raw + MISC_OFF) + 8; xcd_barrier(bar); }
            }
        }
    }
}

extern "C" void kernel_launch(void* const* d_in, const int* in_sizes, int n_in, void* d_out, int out_size, void* d_ws, size_t ws_size, hipStream_t stream) {
    static int grid = 0;
    if (grid == 0) {
        if (n_in != 23 || out_size != M * D || ws_size < WS_END) { fprintf(stderr, "kernel_launch: unexpected shapes/workspace (n_in %d out %d ws %zu need %zu)\n", n_in, out_size, ws_size, (size_t)WS_END); grid = -1; return; }
        int dev = 0, cus = 0, per_cu = 0;
        (void)hipGetDevice(&dev); (void)hipDeviceGetAttribute(&cus, hipDeviceAttributeMultiprocessorCount, dev);
        if (hipFuncSetAttribute((const void*)mega_fwd, hipFuncAttributeMaxDynamicSharedMemorySize, LDS_BYTES) != hipSuccess) { fprintf(stderr, "kernel_launch: hipFuncSetAttribute failed\n"); grid = -1; return; }
        (void)hipOccupancyMaxActiveBlocksPerMultiprocessor(&per_cu, (const void*)mega_fwd, NTHREADS, LDS_BYTES);
        if (per_cu < 1) { fprintf(stderr, "kernel_launch: occupancy query says %d blocks per CU\n", per_cu); grid = -1; return; }
        grid = cus;
    }
    if (grid < 0) return;
    if (hipMemsetAsync((char*)d_ws + WS_CTL, 0, 65536, stream) != hipSuccess) { fprintf(stderr, "kernel_launch: hipMemsetAsync failed\n"); return; }
    Args a{};
    for (int i = 0; i < 23; ++i) a.in[i] = d_in[i];
    a.out = (float*)d_out; a.ws = (unsigned char*)d_ws;
    void* args[] = {&a};
    hipError_t e = hipLaunchCooperativeKernel((const void*)mega_fwd, dim3(grid), dim3(NTHREADS), args, LDS_BYTES, stream);
    if (e != hipSuccess) fprintf(stderr, "cooperative launch failed: %s (grid %d)\n", hipGetErrorString(e), grid);
}
```

```cpp
#include <hip/hip_runtime.h>
#include <hip/hip_cooperative_groups.h>
#include <cstdint>
#include <cstdio>
namespace cg = cooperative_groups;

constexpr int NB = 8, S = 2048, D = 1024, M = NB * S, DEPTH = 4, CH = 64, NCH = S / CH;
constexpr int FF = 4096, PLE = 256;
constexpr int GLA_IN = 3088, GH = 4, GDK = 128, GDV = 256, GHK = 512, GHV = 1024, GRANK = 16;
constexpr int MLA_IN = 576, MLA_INP = 768, MH = 8, MNOPE = 128, MROPE = 64, MV = 128, MQK = 192;
constexpr float ALPHA = 1.6817928305074290860622509524664f;
constexpr float LN_EPS = 1e-5f, RMS_EPS = 1e-6f;

#define LAS __attribute__((address_space(3)))
typedef unsigned short bf16_t;
__device__ __forceinline__ float ldf(const float* p, size_t i) { return p[i]; }
__device__ __forceinline__ float ldf(const bf16_t* p, size_t i) { return __uint_as_float(((unsigned)p[i]) << 16); }
__device__ __forceinline__ unsigned f2bf(float f) { unsigned u = __float_as_uint(f); return (u + 0x7fffu + ((u >> 16) & 1u)) >> 16; }
__device__ __forceinline__ unsigned pk2(float lo, float hi) { return f2bf(lo) | (f2bf(hi) << 16); }
__device__ __forceinline__ float bflo(unsigned w) { return __uint_as_float(w << 16); }
__device__ __forceinline__ float bfhi(unsigned w) { return __uint_as_float(w & 0xffff0000u); }
__device__ __forceinline__ void stf(float* p, size_t i, float v) { p[i] = v; }
__device__ __forceinline__ void stf(bf16_t* p, size_t i, float v) { p[i] = (bf16_t)f2bf(v); }
__device__ __forceinline__ float wave_sum(float v) {
#pragma unroll
    for (int o = 1; o < 64; o <<= 1) v += __shfl_xor(v, o);
    return v;
}
__device__ __forceinline__ float wave_max(float v) {
#pragma unroll
    for (int o = 1; o < 64; o <<= 1) v = fmaxf(v, __shfl_xor(v, o));
    return v;
}
__device__ __forceinline__ float log_sigmoid(float z) { return fminf(z, 0.f) - log1pf(expf(-fabsf(z))); }
__device__ __forceinline__ float sigmoidf_(float z) { return 1.f / (1.f + expf(-z)); }
__device__ const float INV_FREQ[32] = {1.0f, 0.7498942017555237f, 0.5623413324356079f, 0.4216965138912201f, 0.3162277638912201f, 0.23713737726211548f, 0.17782793939113617f, 0.1333521455526352f, 0.10000000149011612f, 0.0749894231557846f, 0.05623413249850273f, 0.04216964915394783f, 0.03162277489900589f, 0.023713737726211548f, 0.017782794311642647f, 0.013335213996469975f, 0.009999999776482582f, 0.007498942315578461f, 0.005623413249850273f, 0.0042169648222625256f, 0.003162277629598975f, 0.0023713738191872835f, 0.0017782794311642647f, 0.0013335214462131262f, 0.0010000000474974513f, 0.0007498941849917173f, 0.000562341301701963f, 0.0004216965171508491f, 0.0003162277571391314f, 0.00023713737027719617f, 0.00017782794020604342f, 0.0001333521504420787f};
__device__ __forceinline__ float inv_freq(int j) { return INV_FREQ[j]; }

constexpr int NTHR = 512;
__device__ __forceinline__ int tid_now() { int t = threadIdx.x; asm volatile("" : "+v"(t)); return t; }
__device__ __forceinline__ int bid_now() { int b = blockIdx.x; asm volatile("" : "+s"(b)); return b; }
__device__ __forceinline__ int nblk_now() { int g = gridDim.x; asm volatile("" : "+s"(g)); return g; }
#define GSTRIDE(i, n) for (size_t i = (size_t)bid_now() * NTHR + tid_now(), _st = (size_t)nblk_now() * NTHR; i < (size_t)(n); i += _st)
#define WSTRIDE_DECL const int _t = tid_now(); const int lane = _t & 63; const size_t gw = ((size_t)bid_now() * NTHR + _t) >> 6, nw = ((size_t)nblk_now() * NTHR) >> 6

template <class T> __device__ __forceinline__ void gla_glr(const T* xb, const float* Win, float* glr, int Mloc) {
    WSTRIDE_DECL;
    for (size_t m = gw; m < (size_t)Mloc; m += nw) {
        float acc[GRANK];
#pragma unroll
        for (int r = 0; r < GRANK; ++r) acc[r] = 0.f;
        for (int i = 0; i < D / 64; ++i) { const int k = lane + 64 * i; const float xv = ldf(xb, m * D + k); const float* w = Win + (size_t)k * GLA_IN + 3072;
#pragma unroll
            for (int r = 0; r < GRANK; ++r) acc[r] += xv * w[r]; }
#pragma unroll
        for (int r = 0; r < GRANK; ++r) { const float s = wave_sum(acc[r]); if (lane == r) glr[m * GRANK + r] = s; }
    }
}
template <class T> __device__ __forceinline__ void gla_L(const T* glr, int ldg, const float* wgu, const float* bg, float* L, int Mloc) {
    GSTRIDE(idx, (size_t)(Mloc / CH) * GHK) {
        const int ch = (int)(idx % GHK); const int cn = (int)(idx / GHK);
        float acc = 0.f;
        for (int t = 0; t < CH; ++t) {
            const size_t m = (size_t)cn * CH + t; float z = bg[ch];
            for (int r = 0; r < GRANK; ++r) z += ldf(glr, m * ldg + r) * wgu[r * GHK + ch];
            acc += log_sigmoid(z) * (1.f / 16.f);
            L[m * GHK + ch] = acc;
        }
    }
}
template <class T, class TO> __device__ __forceinline__ void gla_state(const T* k, int ldk, const T* v, int ldv, const float* L, TO* ST, int nb) {
    GSTRIDE(idx, (size_t)nb * GH * GDK * GDV) {
        const int dv = (int)(idx % GDV), dk = (int)((idx / GDV) % GDK), h = (int)((idx / (GDV * GDK)) % GH), b = (int)(idx / ((size_t)GDV * GDK * GH));
        float st = 0.f;
        for (int n = 0; n < NCH; ++n) {
            stf(ST, (((size_t)(b * GH + h) * NCH + n) * GDK + dk) * GDV + dv, st);
            const size_t m0 = (size_t)b * S + n * CH;
            const float Lend = L[(m0 + CH - 1) * GHK + h * GDK + dk];
            float acc = 0.f;
            for (int s = 0; s < CH; ++s) { const size_t m = m0 + s; acc += ldf(k, m * ldk + h * GDK + dk) * expf(Lend - L[m * GHK + h * GDK + dk]) * ldf(v, m * ldv + h * GDV + dv); }
            st = expf(Lend) * st + acc;
        }
    }
}
template <class T> __device__ __forceinline__ void gla_scores(const T* q, int ldq, const T* k, int ldk, const float* L, float* SC, int nb) {
    GSTRIDE(idx, (size_t)nb * GH * NCH * CH * CH) {
        const int s = (int)(idx % CH), t = (int)((idx / CH) % CH); const size_t unit = idx / (CH * CH);
        const int n = (int)(unit % NCH), h = (int)((unit / NCH) % GH), b = (int)(unit / (NCH * GH));
        const size_t mt = (size_t)b * S + n * CH + t, ms = (size_t)b * S + n * CH + s;
        float acc = 0.f;
        for (int d = 0; d < GDK; ++d) acc += ldf(q, mt * ldq + h * GDK + d) * ldf(k, ms * ldk + h * GDK + d) * expf(-fabsf(L[mt * GHK + h * GDK + d] - L[ms * GHK + h * GDK + d]));
        SC[idx] = acc * 0.088388347648318440550f;
    }
}
template <class T, class TS, class TO> __device__ __forceinline__ void gla_out_norm(const T* q, int ldq, const T* v, int ldv, const T* r, int ldr, const float* L, const float* SC, const TS* ST, const float* g, TO* OG, int Mloc) {
    WSTRIDE_DECL;
    for (size_t it = gw; it < (size_t)Mloc * GH; it += nw) {
        const size_t m = it / GH; const int h = (int)(it % GH);
        const int b = (int)(m / S), tt = (int)(m % S), n = tt / CH, t = tt % CH;
        const size_t unit = (size_t)(b * GH + h) * NCH + n, m0 = (size_t)b * S + n * CH;
        float o[4] = {0.f, 0.f, 0.f, 0.f};
        for (int s = 0; s < CH; ++s) { const float sc = SC[(unit * CH + t) * CH + s];
#pragma unroll
            for (int j = 0; j < 4; ++j) o[j] += sc * ldf(v, (m0 + s) * ldv + h * GDV + lane + 64 * j); }
        float o2[4] = {0.f, 0.f, 0.f, 0.f};
        for (int dk = 0; dk < GDK; ++dk) { const float qe = ldf(q, m * ldq + h * GDK + dk) * expf(L[m * GHK + h * GDK + dk]);
#pragma unroll
            for (int j = 0; j < 4; ++j) o2[j] += qe * ldf(ST, (unit * GDK + dk) * GDV + lane + 64 * j); }
        float ss = 0.f;
#pragma unroll
        for (int j = 0; j < 4; ++j) { o[j] += o2[j] * 0.088388347648318440550f; ss += o[j] * o[j]; }
        const float rstd = rsqrtf(wave_sum(ss) * (1.f / GDV) + RMS_EPS);
#pragma unroll
        for (int j = 0; j < 4; ++j) { const int dv = lane + 64 * j; const float rv = ldf(r, m * ldr + h * GDV + dv); stf(OG, m * GHV + h * GDV + dv, o[j] * rstd * g[dv] * (rv * sigmoidf_(rv))); }
    }
}
template <class T, class TO> __device__ __forceinline__ void mla_prep(const T* Cb, int ldc, const float* qn, const float* kvn, const float* cs, TO* cqn, TO* ckvn, TO* kr, int Mloc) {
    WSTRIDE_DECL;
    for (size_t m = gw; m < (size_t)Mloc; m += nw) {
        float a[4], c[4], sa = 0.f, sc = 0.f;
#pragma unroll
        for (int j = 0; j < 4; ++j) { a[j] = ldf(Cb, m * ldc + lane + 64 * j); c[j] = ldf(Cb, m * ldc + 256 + lane + 64 * j); sa += a[j] * a[j]; sc += c[j] * c[j]; }
        const float ra = rsqrtf(wave_sum(sa) * (1.f / 256.f) + RMS_EPS), rc = rsqrtf(wave_sum(sc) * (1.f / 256.f) + RMS_EPS);
#pragma unroll
        for (int j = 0; j < 4; ++j) { const int d = lane + 64 * j; stf(cqn, m * 256 + d, a[j] * ra * qn[d]); stf(ckvn, m * 256 + d, c[j] * rc * kvn[d]); }
        if (lane < 32) {
            const float x1 = ldf(Cb, m * ldc + 512 + lane), x2 = ldf(Cb, m * ldc + 544 + lane);
            const float csn = cs[m * 64 + lane], sn = cs[m * 64 + 32 + lane];
            stf(kr, m * 64 + lane, x1 * csn - x2 * sn); stf(kr, m * 64 + 32 + lane, x2 * csn + x1 * sn);
        }
    }
}
template <class T> __device__ __forceinline__ void mla_qrope(T* q, const float* cs, int Mloc) {
    GSTRIDE(idx, (size_t)Mloc * MH * 32) {
        const int j = (int)(idx % 32), h = (int)((idx / 32) % MH); const size_t m = idx / (32 * MH);
        const size_t o = m * (MH * MQK) + h * MQK + MNOPE + j;
        const float x1 = ldf(q, o), x2 = ldf(q, o + 32);
        const float csn = cs[m * 64 + j], sn = cs[m * 64 + 32 + j];
        stf(q, o, x1 * csn - x2 * sn); stf(q, o + 32, x2 * csn + x1 * sn);
    }
}
template <class T, class TO> __device__ __forceinline__ void mla_attn(const T* q, const T* kv, const T* kr, TO* o, int nb, float* sc) {
    WSTRIDE_DECL;
    for (size_t it = gw; it < (size_t)nb * MH * S; it += nw) {
        const int qi = (int)(it % S), h = (int)((it / S) % MH), b = (int)(it / ((size_t)S * MH));
        const size_t m = (size_t)b * S + qi; const int lim = (qi / CH + 1) * CH;
        const T* qp = q + m * (MH * MQK) + h * MQK;
        float mx = -INFINITY;
        for (int s = lane; s < lim; s += 64) {
            const size_t ms = (size_t)b * S + s; const T* kp = kv + ms * (MH * 256) + h * 256; const T* rp = kr + ms * 64;
            float dot = 0.f;
            for (int d = 0; d < MNOPE; ++d) dot += ldf(qp, d) * ldf(kp, d);
            for (int j = 0; j < MROPE; ++j) dot += ldf(qp, MNOPE + j) * ldf(rp, j);
            dot *= 0.072168783648703220564f;
            sc[s] = dot; mx = fmaxf(mx, dot);
        }
        mx = wave_max(mx);
        float sum = 0.f;
        for (int s = lane; s < lim; s += 64) { const float p = expf(sc[s] - mx); sc[s] = p; sum += p; }
        sum = wave_sum(sum);
        __builtin_amdgcn_s_waitcnt(0); __builtin_amdgcn_wave_barrier();
        float a0 = 0.f, a1 = 0.f;
        for (int s = 0; s < lim; ++s) { const size_t ms = (size_t)b * S + s; const float p = sc[s]; a0 += p * ldf(kv, ms * (MH * 256) + h * 256 + 128 + lane); a1 += p * ldf(kv, ms * (MH * 256) + h * 256 + 192 + lane); }
        const float inv = 1.f / sum;
        stf(o, m * (MH * MV) + h * MV + lane, a0 * inv); stf(o, m * (MH * MV) + h * MV + 64 + lane, a1 * inv);
        __builtin_amdgcn_s_waitcnt(0); __builtin_amdgcn_wave_barrier();
    }
}
template <class T, class TO> __device__ __forceinline__ void conv_mix(const T* bcu, int ld, const float* cw, TO* a, int Mloc) {
    GSTRIDE(idx, (size_t)Mloc * D) {
        const int c = (int)(idx % D); const size_t m = idx / D; const int t = (int)(m % S);
        float z = 0.f;
#pragma unroll
        for (int j = 0; j < 3; ++j) { const int dt = 2 - j; if (t - dt >= 0) { const size_t mm = m - dt; z += cw[j * D + c] * ldf(bcu, mm * ld + D + c) * ldf(bcu, mm * ld + 2 * D + c); } }
        stf(a, idx, ldf(bcu, m * ld + c) * z);
    }
}

template <class T, class TO> __device__ __forceinline__ void gla_state2(const T* proj, const float* DEC, TO* ST, int nb) {
    GSTRIDE(idx, (size_t)nb * GH * GDK * GDV) {
        const int dk = (int)(idx % GDK), dv = (int)((idx / GDK) % GDV), h = (int)((idx / (GDV * GDK)) % GH), b = (int)(idx / ((size_t)GDV * GDK * GH));
        float st = 0.f;
        for (int n = 0; n < NCH; ++n) {
            stf(ST, (((size_t)(b * GH + h) * NCH + n) * GDV + dv) * GDK + dk, st);
            const size_t m0 = (size_t)b * S + n * CH; float acc = 0.f;
            for (int s = 0; s < CH; ++s) { const size_t m = m0 + s; acc += ldf(proj, m * 4096 + 1536 + h * GDK + dk) * ldf(proj, m * 4096 + 2048 + h * GDV + dv); }
            st = DEC[((size_t)b * NCH + n) * GHK + h * GDK + dk] * (st + acc);
        }
    }
}

__device__ __forceinline__ void conv_mix_vec(const bf16_t* __restrict__ bcu, const float* __restrict__ cw, bf16_t* __restrict__ out) {
    typedef unsigned u4 __attribute__((ext_vector_type(4))); typedef float f4 __attribute__((ext_vector_type(4)));
    GSTRIDE(idx, (size_t)(M / 4) * (D / 8)) {
        const int cg = (int)(idx % (D / 8)); const size_t m0 = (idx / (D / 8)) * 4; const int c0 = cg * 8; const bool first = (m0 % S) == 0;
        float w[3][8];
#pragma unroll
        for (int j = 0; j < 3; ++j) { const f4 a0 = *(const f4*)(cw + j * D + c0), a1 = *(const f4*)(cw + j * D + c0 + 4); w[j][0] = a0[0]; w[j][1] = a0[1]; w[j][2] = a0[2]; w[j][3] = a0[3]; w[j][4] = a1[0]; w[j][5] = a1[1]; w[j][6] = a1[2]; w[j][7] = a1[3]; }
        u4 cv[6], uv[6], bv[4];
#pragma unroll
        for (int k = 0; k < 6; ++k) { const bool ok = (k >= 2) || !first; const size_t mm = ok ? (m0 + k - 2) : m0; cv[k] = *(const u4*)(bcu + mm * (3 * D) + D + c0); uv[k] = *(const u4*)(bcu + mm * (3 * D) + 2 * D + c0);
            if (!ok) { cv[k] = (u4){0u, 0u, 0u, 0u}; } }
#pragma unroll
        for (int t = 0; t < 4; ++t) bv[t] = *(const u4*)(bcu + (m0 + t) * (3 * D) + c0);
        float cu[6][8];
#pragma unroll
        for (int k = 0; k < 6; ++k)
#pragma unroll
            for (int e = 0; e < 4; ++e) { cu[k][2 * e] = bflo(cv[k][e]) * bflo(uv[k][e]); cu[k][2 * e + 1] = bfhi(cv[k][e]) * bfhi(uv[k][e]); }
#pragma unroll
        for (int t = 0; t < 4; ++t) { u4 o;
#pragma unroll
            for (int e = 0; e < 4; ++e) { const float z0 = w[0][2 * e] * cu[t][2 * e] + w[1][2 * e] * cu[t + 1][2 * e] + w[2][2 * e] * cu[t + 2][2 * e], z1 = w[0][2 * e + 1] * cu[t][2 * e + 1] + w[1][2 * e + 1] * cu[t + 1][2 * e + 1] + w[2][2 * e + 1] * cu[t + 2][2 * e + 1];
                o[e] = pk2(bflo(bv[t][e]) * z0, bfhi(bv[t][e]) * z1); }
            *(u4*)(out + (m0 + t) * D + c0) = o; }
    }
}
namespace pg8 {
#define PG8_LAS __attribute__((address_space(3)))
typedef unsigned short bf16_t;
typedef short bf16x8 __attribute__((ext_vector_type(8)));
typedef float f32x4 __attribute__((ext_vector_type(4)));
typedef unsigned u32x4 __attribute__((ext_vector_type(4)));
constexpr int BM = 256, BK = 64, HALF = 128, HTB = HALF * BK * 2  , STAGE_BYTES = 8 * HTB, NXCD = 8, WGM = 8;

__host__ __device__ __forceinline__ int lds_byte(int r, int c) { const int st = (r >> 4) * 2 + (c >> 5), rr = r & 15, cc = c & 31, ob = rr * 64 + cc * 2; return st * 1024 + (ob ^ (((ob >> 9) & 1) << 5)); }
__host__ __device__ __forceinline__ void stage_rc(int b, int& R, int& C) { const int st = b / 1024, sb = b % 1024, swz = sb ^ (((sb >> 9) & 1) << 5); R = (st >> 1) * 16 + swz / 64; C = (st & 1) * 32 + (swz % 64) / 2; }
__host__ __device__ __forceinline__ int perm32(int rho) { const int n = rho >> 4, i = rho & 15; return 8 * (i >> 2) + 4 * n + (i & 3); }

struct Unit { int pm, pn; };
struct Gemm { const bf16_t* A; const bf16_t* Bt; int M, N, K; };

struct StaticOrder {
    int nM, nN, nwg, G, c;
    __host__ __device__ void init(int M, int N, int G_, int c_) { nM = M / BM; nN = N / BM; nwg = nM * nN; G = G_; c = c_; }
    __host__ __device__ bool next(int i, Unit& u) const {
        const long L = (long)i * G + c; if (L >= nwg) return false;
        int wgid = (int)L; { const int q = nwg / NXCD, r = nwg % NXCD, xcd = wgid % NXCD, off = wgid / NXCD; wgid = (xcd < r ? xcd * (q + 1) : r * (q + 1) + (xcd - r) * q) + off; }
        const int nig = WGM * nN, gid = wgid / nig, fm = gid * WGM, gsz = (nM - fm) < WGM ? (nM - fm) : WGM;
        u.pm = fm + ((wgid % nig) % gsz); u.pn = (wgid % nig) / gsz; return true;
    }
    __device__ __forceinline__ void a_ready(const Unit&) const {}
    __device__ __forceinline__ void done(const Unit&) const {}
};


__device__ __forceinline__ unsigned cvt_pk_bf16(float lo, float hi) { unsigned r; asm volatile("v_cvt_pk_bf16_f32 %0, %1, %2" : "=v"(r) : "v"(lo), "v"(hi)); return r; }
typedef unsigned u32x2 __attribute__((ext_vector_type(2)));
template <int ACT  > struct EpiBf16 {
    static constexpr bool PERM = true, AFTER_DRAIN = false;
    bf16_t* O; int ldc;
    __device__ __forceinline__ void operator()(const f32x4 (&acc)[2][2][4][2], const Unit& u, int wr, int wc, int fr, int fq) const {
        const int row0 = u.pm * BM + wr * 64 + fr, col0 = u.pn * BM + wc * 32 + 8 * fq;
#pragma unroll
        for (int ai = 0; ai < 2; ++ai)
#pragma unroll
            for (int m = 0; m < 4; ++m) { bf16_t* rowp = O + (size_t)(row0 + ai * HALF + m * 16) * ldc + col0;
#pragma unroll
                for (int bj = 0; bj < 2; ++bj) { f32x4 v0 = acc[ai][bj][m][0], v1 = acc[ai][bj][m][1];
                    if (ACT == 2) {
#pragma unroll
                        for (int e = 0; e < 4; ++e) { float a = fmaxf(v0[e], 0.f); v0[e] = a * a; float b = fmaxf(v1[e], 0.f); v1[e] = b * b; } }
                    u32x4 w; w.x = cvt_pk_bf16(v0[0], v0[1]); w.y = cvt_pk_bf16(v0[2], v0[3]); w.z = cvt_pk_bf16(v1[0], v1[1]); w.w = cvt_pk_bf16(v1[2], v1[3]);
                    *(u32x4*)(rowp + bj * HALF) = w; } }
    }
};
struct EpiRes {
    static constexpr bool PERM = false, AFTER_DRAIN = false;
    const float* base; float* out; int ldc; float alpha;
    __device__ __forceinline__ void operator()(const f32x4 (&acc)[2][2][4][2], const Unit& u, int wr, int wc, int fr, int fq) const {
        const int col0 = u.pn * BM + wc * 32 + 4 * fq;
#pragma unroll
        for (int ai = 0; ai < 2; ++ai)
#pragma unroll
            for (int m = 0; m < 4; ++m) { const size_t off = (size_t)(u.pm * BM + ai * HALF + wr * 64 + m * 16 + fr) * ldc + col0;
#pragma unroll
                for (int bj = 0; bj < 2; ++bj)
#pragma unroll
                    for (int n = 0; n < 2; ++n) { const f32x4 bs = *(const f32x4*)(base + off + bj * HALF + n * 16); *(f32x4*)(out + off + bj * HALF + n * 16) = bs * alpha + acc[ai][bj][m][n]; } }
    }
};
struct EpiPle {
    static constexpr bool PERM = false, AFTER_DRAIN = false;
    const float* xin; float* xout; const bf16_t* P; bf16_t* xb; int ldc;
    __device__ __forceinline__ void operator()(const f32x4 (&acc)[2][2][4][2], const Unit& u, int wr, int wc, int fr, int fq) const {
        const int col0 = u.pn * BM + wc * 32 + 4 * fq;
#pragma unroll
        for (int ai = 0; ai < 2; ++ai)
#pragma unroll
            for (int m = 0; m < 4; ++m) { const size_t off = (size_t)(u.pm * BM + ai * HALF + wr * 64 + m * 16 + fr) * ldc + col0;
#pragma unroll
                for (int bj = 0; bj < 2; ++bj)
#pragma unroll
                    for (int n = 0; n < 2; ++n) { const size_t o = off + bj * HALF + n * 16; const f32x4 x2 = *(const f32x4*)(xin + o); const u32x2 pw = *(const u32x2*)(P + o); const f32x4 a = acc[ai][bj][m][n];
                        f32x4 r; r[0] = x2[0] + __uint_as_float(pw.x << 16) / (1.f + __expf(-a[0])); r[1] = x2[1] + __uint_as_float(pw.x & 0xffff0000u) / (1.f + __expf(-a[1]));
                        r[2] = x2[2] + __uint_as_float(pw.y << 16) / (1.f + __expf(-a[2])); r[3] = x2[3] + __uint_as_float(pw.y & 0xffff0000u) / (1.f + __expf(-a[3]));
                        *(f32x4*)(xout + o) = r; u32x2 w; w.x = cvt_pk_bf16(r[0], r[1]); w.y = cvt_pk_bf16(r[2], r[3]); *(u32x2*)(xb + o) = w; } }
    }
};

struct EpiGla {
    static constexpr bool PERM = true, AFTER_DRAIN = false;
    bf16_t* O; const float* L;
    __device__ __forceinline__ void operator()(const f32x4 (&acc)[2][2][4][2], const Unit& u, int wr, int wc, int fr, int fq) const {
        const int row0 = u.pm * BM + wr * 64 + fr, cl = wc * 32 + 8 * fq;
        if (u.pn >= 4) {
#pragma unroll
            for (int ai = 0; ai < 2; ++ai)
#pragma unroll
                for (int m = 0; m < 4; ++m) { bf16_t* rowp = O + (size_t)(row0 + ai * HALF + m * 16) * 4096 + 1024 + u.pn * BM + cl;
#pragma unroll
                    for (int bj = 0; bj < 2; ++bj) { const f32x4 v0 = acc[ai][bj][m][0], v1 = acc[ai][bj][m][1];
                        u32x4 w; w.x = cvt_pk_bf16(v0[0], v0[1]); w.y = cvt_pk_bf16(v0[2], v0[3]); w.z = cvt_pk_bf16(v1[0], v1[1]); w.w = cvt_pk_bf16(v1[2], v1[3]);
                        *(u32x4*)(rowp + bj * HALF) = w; } }
        } else {
            const bool isq = u.pn < 2; const float sc = isq ? 0.088388347648318440550f : 1.f;
            const int ch0 = (u.pn & 1) * BM + cl;
            const int ob = isq ? 0 : 1024;
#pragma unroll
            for (int ai = 0; ai < 2; ++ai)
#pragma unroll
                for (int m = 0; m < 4; ++m) { const size_t r = (size_t)(row0 + ai * HALF + m * 16);
#pragma unroll
                    for (int bj = 0; bj < 2; ++bj) { const int ch = ch0 + bj * HALF;
                        const f32x4 l0 = *(const f32x4*)(L + r * 512 + ch), l1 = *(const f32x4*)(L + r * 512 + ch + 4);
                        f32x4 v0 = acc[ai][bj][m][0] * sc, v1 = acc[ai][bj][m][1] * sc, p0, p1, n0, n1;
#pragma unroll
                        for (int e = 0; e < 4; ++e) { const float e0 = __expf(l0[e]), e1 = __expf(l1[e]); p0[e] = v0[e] * e0; p1[e] = v1[e] * e1; n0[e] = v0[e] * __expf(-l0[e]); n1[e] = v1[e] * __expf(-l1[e]); }
                        u32x4 w; w.x = cvt_pk_bf16(p0[0], p0[1]); w.y = cvt_pk_bf16(p0[2], p0[3]); w.z = cvt_pk_bf16(p1[0], p1[1]); w.w = cvt_pk_bf16(p1[2], p1[3]);
                        *(u32x4*)(O + r * 4096 + ob + ch) = w;
                        w.x = cvt_pk_bf16(n0[0], n0[1]); w.y = cvt_pk_bf16(n0[2], n0[3]); w.z = cvt_pk_bf16(n1[0], n1[1]); w.w = cvt_pk_bf16(n1[2], n1[3]);
                        *(u32x4*)(O + r * 4096 + ob + 512 + ch) = w; } }
        }
    }
};
template <class Epi, class Sched, bool ALIGN_EPI = false, bool SP2 = false>
__device__ __forceinline__ void gemm_phase(PG8_LAS unsigned char* lds, const Gemm g, const Sched& S, const Epi& E) {
    const int tid = tid_now(), wid = __builtin_amdgcn_readfirstlane(tid >> 6), lane = tid & 63, wr = wid >> 2, wc = wid & 3, fr = lane & 15, fq = lane >> 4;
    const int K = g.K, nt = K / BK;
    unsigned voffA[2], voffB[2];
#pragma unroll
    for (int i = 0; i < 2; ++i) { int R, C; stage_rc(tid * 16 + i * 8192, R, C); const int Rb = Epi::PERM ? ((R & ~31) + perm32(R & 31)) : R;
        voffA[i] = (unsigned)(R * K + C) * 2u; voffB[i] = (unsigned)(Rb * K + C) * 2u; }
    const size_t kstep = (size_t)(BK * 2);
    const size_t hstep = (size_t)HALF * K * 2;
    const size_t tstep = 2 * hstep;
    const unsigned ldsw = (unsigned)wid * 1024u;
    const int aoff = lds_byte(wr * 64 + fr, fq * 8), boff = lds_byte(wc * 32 + fr, fq * 8);
#define PG8_SA(b, h) (((b) * 2 + (h)) * HTB)
#define PG8_SB(b, h) ((4 + (b) * 2 + (h)) * HTB)
#define PG8_STAGE(bufoff, gbase, voff) do { _Pragma("unroll") for (int _i = 0; _i < 2; ++_i) \
        __builtin_amdgcn_global_load_lds((const unsigned*)((const char*)(gbase) + (voff)[_i]), (PG8_LAS unsigned*)(lds + (bufoff) + ldsw + _i * 8192), 16, 0, 0); } while (0)
#define PG8_LDA(dst, b, h) do { _Pragma("unroll") for (int m = 0; m < 4; ++m) _Pragma("unroll") for (int k = 0; k < 2; ++k) dst[m][k] = *(const PG8_LAS bf16x8*)(lds + PG8_SA(b, h) + aoff + m * 2048 + k * 1024); } while (0)
#define PG8_LDB(dst, b, h) do { _Pragma("unroll") for (int n = 0; n < 2; ++n) _Pragma("unroll") for (int k = 0; k < 2; ++k) dst[n][k] = *(const PG8_LAS bf16x8*)(lds + PG8_SB(b, h) + boff + n * 2048 + k * 1024); } while (0)
#define PG8_MMA(ai, bj, At, Bt) do { __builtin_amdgcn_s_setprio(1); _Pragma("unroll") for (int m = 0; m < 4; ++m) _Pragma("unroll") for (int n = 0; n < 2; ++n) _Pragma("unroll") for (int k = 0; k < 2; ++k) \
        acc[ai][bj][m][n] = __builtin_amdgcn_mfma_f32_16x16x32_bf16(Bt[n][k], At[m][k], acc[ai][bj][m][n], 0, 0, 0); __builtin_amdgcn_s_setprio(0); } while (0)
#define PG8_WAIT_V(n) asm volatile("s_waitcnt vmcnt(" #n ")" ::: "memory")
#define PG8_WAIT_L(n) asm volatile("s_waitcnt lgkmcnt(" #n ")" ::: "memory")
#define PG8_BAR __builtin_amdgcn_s_barrier()
#define PG8_SCHED __builtin_amdgcn_sched_barrier(0)
    Unit cur, nxt; int ui = 0;
    if (!S.next(0, cur)) return;
    f32x4 acc[2][2][4][2];
#pragma unroll
    for (int a = 0; a < 2; ++a)
#pragma unroll
        for (int b = 0; b < 2; ++b)
#pragma unroll
            for (int m = 0; m < 4; ++m)
#pragma unroll
                for (int n = 0; n < 2; ++n) acc[a][b][m][n] = (f32x4){0.f, 0.f, 0.f, 0.f};
    bf16x8 At[4][2], B0[2][2], B1[2][2];
    const char* cA = (const char*)g.A + (size_t)cur.pm * tstep; const char* cB = (const char*)g.Bt + (size_t)cur.pn * tstep;
    S.a_ready(cur);
    if constexpr (SP2) {
        PG8_STAGE(PG8_SB(0, 0), cB, voffB); PG8_STAGE(PG8_SB(0, 1), cB + hstep, voffB); PG8_STAGE(PG8_SA(0, 0), cA, voffA); PG8_STAGE(PG8_SA(0, 1), cA + hstep, voffA);
        if (wr == 1) PG8_BAR;
        PG8_WAIT_V(2); PG8_BAR;
        PG8_STAGE(PG8_SB(1, 0), cB + kstep, voffB); PG8_STAGE(PG8_SA(1, 0), cA + kstep, voffA); PG8_STAGE(PG8_SB(1, 1), cB + hstep + kstep, voffB);
        PG8_WAIT_V(6); PG8_BAR;
    } else {
        PG8_STAGE(PG8_SB(0, 0), cB, voffB); PG8_STAGE(PG8_SA(0, 0), cA, voffA); PG8_STAGE(PG8_SB(0, 1), cB + hstep, voffB); PG8_STAGE(PG8_SA(0, 1), cA + hstep, voffA);
        if (wr == 1) PG8_BAR;
        PG8_WAIT_V(4); PG8_BAR;
        PG8_STAGE(PG8_SB(1, 0), cB + kstep, voffB); PG8_STAGE(PG8_SA(1, 0), cA + kstep, voffA); PG8_STAGE(PG8_SB(1, 1), cB + hstep + kstep, voffB);
        PG8_WAIT_V(6); PG8_BAR;
    }
    for (;;) {
        const bool has_next = S.next(ui + 1, nxt);
        const char* nA = has_next ? (const char*)g.A + (size_t)nxt.pm * tstep : cA; const char* nB = has_next ? (const char*)g.Bt + (size_t)nxt.pn * tstep : cB;
        for (int t = 0; t < nt; t += 2) {
            const bool last = (t == nt - 2);
            const char* a1 = cA + (size_t)(t + 1) * kstep;
            const char* a2 = last ? nA : cA + (size_t)(t + 2) * kstep; const char* b2 = last ? nB : cB + (size_t)(t + 2) * kstep;
            const char* a3 = a2 + kstep; const char* b3 = b2 + kstep;
            if (last && has_next) S.a_ready(nxt);
            if constexpr (SP2) {
            PG8_LDB(B0, 0, 0); PG8_LDB(B1, 0, 1); PG8_SCHED; PG8_LDA(At, 0, 0); PG8_STAGE(PG8_SA(1, 1), a1 + hstep, voffA);
            PG8_WAIT_V(8); PG8_WAIT_L(0); PG8_BAR; PG8_MMA(0, 0, At, B0); PG8_MMA(0, 1, At, B1); PG8_BAR; PG8_SCHED;
            PG8_LDA(At, 0, 1); PG8_STAGE(PG8_SB(0, 0), b2, voffB); PG8_STAGE(PG8_SB(0, 1), b2 + hstep, voffB); PG8_STAGE(PG8_SA(0, 0), a2, voffA);
            PG8_WAIT_V(8); PG8_WAIT_L(0); PG8_BAR; PG8_MMA(1, 0, At, B0); PG8_MMA(1, 1, At, B1); PG8_BAR; PG8_SCHED;
            PG8_LDB(B0, 1, 0); PG8_LDB(B1, 1, 1); PG8_SCHED; PG8_LDA(At, 1, 0); PG8_STAGE(PG8_SA(0, 1), a2 + hstep, voffA);
            PG8_WAIT_V(8); PG8_WAIT_L(0); PG8_BAR; PG8_MMA(0, 0, At, B0); PG8_MMA(0, 1, At, B1); PG8_BAR; PG8_SCHED;
            PG8_LDA(At, 1, 1); PG8_STAGE(PG8_SB(1, 0), b3, voffB); PG8_STAGE(PG8_SB(1, 1), b3 + hstep, voffB); PG8_STAGE(PG8_SA(1, 0), a3, voffA);
            PG8_WAIT_V(8); PG8_WAIT_L(0); PG8_BAR; PG8_MMA(1, 0, At, B0); PG8_MMA(1, 1, At, B1); PG8_BAR; PG8_SCHED;
            } else {
            PG8_LDB(B0, 0, 0); PG8_SCHED; PG8_LDA(At, 0, 0); PG8_STAGE(PG8_SA(1, 1), a1 + hstep, voffA);
            PG8_WAIT_L(8); PG8_BAR; PG8_WAIT_L(0); PG8_MMA(0, 0, At, B0); PG8_BAR; PG8_SCHED;
            PG8_LDB(B1, 0, 1); PG8_STAGE(PG8_SB(0, 0), b2, voffB);
            PG8_BAR; PG8_WAIT_L(0); PG8_MMA(0, 1, At, B1); PG8_BAR;
            PG8_LDA(At, 0, 1); PG8_STAGE(PG8_SA(0, 0), a2, voffA);
            PG8_BAR; PG8_WAIT_L(0); PG8_MMA(1, 0, At, B0); PG8_BAR; PG8_SCHED;
            PG8_STAGE(PG8_SB(0, 1), b2 + hstep, voffB);
            PG8_WAIT_V(6); PG8_BAR; PG8_MMA(1, 1, At, B1); PG8_BAR;
            PG8_LDB(B0, 1, 0); PG8_SCHED; PG8_LDA(At, 1, 0); PG8_STAGE(PG8_SA(0, 1), a2 + hstep, voffA);
            PG8_WAIT_L(8); PG8_BAR; PG8_WAIT_L(0); PG8_MMA(0, 0, At, B0); PG8_BAR; PG8_SCHED;
            PG8_LDB(B1, 1, 1); PG8_STAGE(PG8_SB(1, 0), b3, voffB);
            PG8_BAR; PG8_WAIT_L(0); PG8_MMA(0, 1, At, B1); PG8_BAR;
            PG8_LDA(At, 1, 1); PG8_STAGE(PG8_SA(1, 0), a3, voffA);
            PG8_BAR; PG8_WAIT_L(0); PG8_MMA(1, 0, At, B0); PG8_BAR; PG8_SCHED;
            PG8_STAGE(PG8_SB(1, 1), b3 + hstep, voffB);
            PG8_WAIT_V(6); PG8_BAR; PG8_MMA(1, 1, At, B1); PG8_BAR;
            }
        }
        if constexpr (ALIGN_EPI) { if (wr == 0) PG8_BAR; }
        if constexpr (!Epi::AFTER_DRAIN) { E(acc, cur, wr, wc, fr, fq); S.done(cur); }
        if (!has_next) break;
#pragma unroll
        for (int a = 0; a < 2; ++a)
#pragma unroll
            for (int b = 0; b < 2; ++b)
#pragma unroll
                for (int m = 0; m < 4; ++m)
#pragma unroll
                    for (int n = 0; n < 2; ++n) acc[a][b][m][n] = (f32x4){0.f, 0.f, 0.f, 0.f};
        cur = nxt; cA = nA; cB = nB; ++ui;
        if constexpr (ALIGN_EPI) { if (wr == 1) PG8_BAR; }
    }
    PG8_WAIT_V(0);
    if constexpr (!ALIGN_EPI) { if (wr == 0) PG8_BAR; }
    PG8_BAR;
    if constexpr (Epi::AFTER_DRAIN) { E.fused(acc, cur, wr, wc, fr, fq, lds, wid, lane); S.done(cur); }
#undef PG8_SA
#undef PG8_SB
#undef PG8_STAGE
#undef PG8_LDA
#undef PG8_LDB
#undef PG8_MMA
#undef PG8_WAIT_V
#undef PG8_WAIT_L
#undef PG8_BAR
#undef PG8_SCHED
}
}

namespace mla {
typedef short bf16x8 __attribute__((ext_vector_type(8)));
typedef short s16x4 __attribute__((ext_vector_type(4)));
typedef float f32x16 __attribute__((ext_vector_type(16)));
typedef unsigned u32x4 __attribute__((ext_vector_type(4)));
typedef unsigned u32x2 __attribute__((ext_vector_type(2)));
constexpr int KRS = 400, VRS = 320;
constexpr int KT_BYTES = 64 * KRS, VT_BYTES = 64 * VRS, BUF_BYTES = KT_BYTES + VT_BYTES;
__device__ __forceinline__ unsigned cvtpk(float lo, float hi) { typedef float f2 __attribute__((ext_vector_type(2))); typedef __bf16 b2 __attribute__((ext_vector_type(2))); f2 v = {lo, hi}; b2 b = __builtin_convertvector(v, b2); return __builtin_bit_cast(unsigned, b); }
__device__ __forceinline__ float half_max(float v) { auto rr = __builtin_amdgcn_permlane32_swap(__float_as_uint(v), __float_as_uint(v), false, false); return fmaxf(__uint_as_float(rr[0]), __uint_as_float(rr[1])); }
__device__ __forceinline__ float half_sum(float v) { auto rr = __builtin_amdgcn_permlane32_swap(__float_as_uint(v), __float_as_uint(v), false, false); return __uint_as_float(rr[0]) + __uint_as_float(rr[1]); }

__device__ __forceinline__ void attn_unit(LAS unsigned char* lds, const bf16_t* __restrict__ q, const bf16_t* __restrict__ kv, const bf16_t* __restrict__ kr, bf16_t* __restrict__ o, int b, int h, int qb, int tid) {
    const int lane = tid & 63, wave = __builtin_amdgcn_readfirstlane(tid >> 6), r32 = lane & 31, hi = lane >> 5;
    const size_t row0 = (size_t)b * S; const int q0 = qb * 256;
    const int NT = 4 * qb + 4, my_nt = 4 * qb + (wave >> 1) + 1;
    bf16x8 qf[12];
    { const bf16_t* qp = q + (row0 + q0 + wave * 32 + r32) * (MH * MQK) + h * MQK + 8 * hi;
#pragma unroll
      for (int ks = 0; ks < 12; ++ks) qf[ks] = *(const bf16x8*)(qp + 16 * ks); }
    const int srow = tid >> 4, sch = tid & 15, rrow = tid >> 3, rch = tid & 7;
    const bf16_t* gk = kv + (row0 + srow) * (MH * 256) + h * 256 + sch * 8;
    const bf16_t* gr = kr + (row0 + rrow) * 64 + rch * 8;
    const unsigned dk0 = srow * KRS + sch * 16, dr0 = rrow * KRS + 256 + rch * 16, dv0 = KT_BYTES + srow * VRS + sch * 16;
    u32x4 st[5];
#define MLA_ISSUE(t) do { const bf16_t* gk_ = gk + (size_t)(t) * 64 * (MH * 256); st[0] = *(const u32x4*)(gk_); st[1] = *(const u32x4*)(gk_ + (size_t)32 * (MH * 256)); \
        st[2] = *(const u32x4*)(gr + (size_t)(t) * 64 * 64); st[3] = *(const u32x4*)(gk_ + 128); st[4] = *(const u32x4*)(gk_ + (size_t)32 * (MH * 256) + 128); } while (0)
#define MLA_COMMIT(buf) do { LAS unsigned char* b_ = lds + (buf) * BUF_BYTES; *(LAS u32x4*)(b_ + dk0) = st[0]; *(LAS u32x4*)(b_ + dk0 + 32 * KRS) = st[1]; *(LAS u32x4*)(b_ + dr0) = st[2]; \
        *(LAS u32x4*)(b_ + dv0) = st[3]; *(LAS u32x4*)(b_ + dv0 + 32 * VRS) = st[4]; } while (0)
    const unsigned ka = r32 * KRS + hi * 16;
    const unsigned va = KT_BYTES + (4 * hi + ((lane & 15) >> 2)) * VRS + (16 * ((lane >> 4) & 1) + 4 * (lane & 3)) * 2;
    float m = -1e30f, l = 0.f;
    f32x16 O[4];
#pragma unroll
    for (int d = 0; d < 4; ++d)
#pragma unroll
        for (int r = 0; r < 16; ++r) O[d][r] = 0.f;
    const float c = 0.072168783648703220564f * 1.4426950408889634f;
    MLA_ISSUE(0); MLA_COMMIT(0); if (NT > 1) MLA_ISSUE(1);
    __syncthreads();
    for (int t = 0; t < NT; ++t) {
        const int buf = t & 1;
        if (t + 1 < NT) MLA_COMMIT(buf ^ 1);
        if (t + 2 < NT) MLA_ISSUE(t + 2);
        if (t < my_nt) {
            LAS unsigned char* kb = lds + buf * BUF_BYTES;
            f32x16 s0, s1;
#pragma unroll
            for (int r = 0; r < 16; ++r) { s0[r] = 0.f; s1[r] = 0.f; }
#pragma unroll
            for (int ks = 0; ks < 12; ++ks) {
                const bf16x8 a0 = *(const LAS bf16x8*)(kb + ka + ks * 32), a1 = *(const LAS bf16x8*)(kb + ka + 32 * KRS + ks * 32);
                s0 = __builtin_amdgcn_mfma_f32_32x32x16_bf16(a0, qf[ks], s0, 0, 0, 0);
                s1 = __builtin_amdgcn_mfma_f32_32x32x16_bf16(a1, qf[ks], s1, 0, 0, 0);
            }
            float mx = fmaxf(s0[0], s1[0]);
#pragma unroll
            for (int r = 1; r < 16; ++r) mx = fmaxf(mx, fmaxf(s0[r], s1[r]));
            mx = half_max(mx);
            const float mn = fmaxf(m, mx * c), alpha = __builtin_amdgcn_exp2f(m - mn); m = mn;
            float ps = 0.f;
#pragma unroll
            for (int r = 0; r < 16; ++r) { s0[r] = __builtin_amdgcn_exp2f(s0[r] * c - mn); s1[r] = __builtin_amdgcn_exp2f(s1[r] * c - mn); ps += s0[r] + s1[r]; }
            l = l * alpha + ps;
#pragma unroll
            for (int d = 0; d < 4; ++d)
#pragma unroll
                for (int r = 0; r < 16; ++r) O[d][r] *= alpha;
            u32x4 pf[4];
#pragma unroll
            for (int s = 0; s < 2; ++s) {
                pf[s] = (u32x4){cvtpk(s0[8 * s], s0[8 * s + 1]), cvtpk(s0[8 * s + 2], s0[8 * s + 3]), cvtpk(s0[8 * s + 4], s0[8 * s + 5]), cvtpk(s0[8 * s + 6], s0[8 * s + 7])};
                pf[2 + s] = (u32x4){cvtpk(s1[8 * s], s1[8 * s + 1]), cvtpk(s1[8 * s + 2], s1[8 * s + 3]), cvtpk(s1[8 * s + 4], s1[8 * s + 5]), cvtpk(s1[8 * s + 6], s1[8 * s + 7])};
            }
#pragma unroll
            for (int d = 0; d < 4; ++d)
#pragma unroll
                for (int f = 0; f < 4; ++f) {
                    const s16x4 lo = __builtin_bit_cast(s16x4, __builtin_amdgcn_ds_read_tr16_b64_v4i16((LAS s16x4*)(kb + va + (16 * f) * VRS + d * 64)));
                    const s16x4 hh = __builtin_bit_cast(s16x4, __builtin_amdgcn_ds_read_tr16_b64_v4i16((LAS s16x4*)(kb + va + (16 * f + 8) * VRS + d * 64)));
                    const bf16x8 vt = (bf16x8){lo[0], lo[1], lo[2], lo[3], hh[0], hh[1], hh[2], hh[3]};
                    O[d] = __builtin_amdgcn_mfma_f32_32x32x16_bf16(vt, __builtin_bit_cast(bf16x8, pf[f]), O[d], 0, 0, 0);
                }
        }
        __syncthreads();
    }
#undef MLA_ISSUE
#undef MLA_COMMIT
    l = half_sum(l);
    const float inv = 1.f / l;
    bf16_t* op = o + (row0 + q0 + wave * 32 + r32) * (MH * MV) + h * MV + 4 * hi;
#pragma unroll
    for (int d = 0; d < 4; ++d)
#pragma unroll
        for (int g = 0; g < 4; ++g) { u32x2 w; w.x = cvtpk(O[d][4 * g] * inv, O[d][4 * g + 1] * inv); w.y = cvtpk(O[d][4 * g + 2] * inv, O[d][4 * g + 3] * inv); *(u32x2*)(op + 32 * d + 8 * g) = w; }
}
__device__ __forceinline__ void attn_phase(LAS unsigned char* lds, const bf16_t* q, const bf16_t* kv, const bf16_t* kr, bf16_t* o, int bid, int nblk, int tid) {
    for (int u = bid; u < NB * MH * 4; u += nblk) {
        const int bh = u >> 2, s = u & 3;
        attn_unit(lds, q, kv, kr, o, bh / MH, bh % MH, s, tid);
        attn_unit(lds, q, kv, kr, o, bh / MH, bh % MH, 7 - s, tid);
    }
}
}

namespace gla {
typedef short bf16x8 __attribute__((ext_vector_type(8)));
typedef float f32x4v __attribute__((ext_vector_type(4)));
__device__ __forceinline__ void l_units(LAS unsigned char* lds, const bf16_t* __restrict__ xb, const bf16_t* __restrict__ wlr, const float* __restrict__ wgu, const float* __restrict__ bg, float* __restrict__ L, float* __restrict__ DEC, int bid, int nblk, int tid) {
    const int lane = tid & 63, wave = __builtin_amdgcn_readfirstlane(tid >> 6), fr = lane & 15, fq = lane >> 4;
    LAS float* part = (LAS float*)lds;
    LAS float* G = (LAS float*)(lds + 32768);
    for (int cn = bid; cn < M / CH; cn += nblk) {
        const size_t m0 = (size_t)cn * CH;
        f32x4v acc[4];
#pragma unroll
        for (int rt = 0; rt < 4; ++rt) acc[rt] = (f32x4v){0.f, 0.f, 0.f, 0.f};
#pragma unroll
        for (int ks = 0; ks < 4; ++ks) {
            const int k0 = wave * 128 + ks * 32 + fq * 8;
            const bf16x8 bfrag = *(const bf16x8*)(wlr + (size_t)fr * D + k0);
#pragma unroll
            for (int rt = 0; rt < 4; ++rt) { const bf16x8 afrag = *(const bf16x8*)(xb + (m0 + rt * 16 + fr) * D + k0); acc[rt] = __builtin_amdgcn_mfma_f32_16x16x32_bf16(afrag, bfrag, acc[rt], 0, 0, 0); }
        }
#pragma unroll
        for (int rt = 0; rt < 4; ++rt)
#pragma unroll
            for (int e = 0; e < 4; ++e) part[(wave * 64 + rt * 16 + fq * 4 + e) * 16 + fr] = acc[rt][e];
        __syncthreads();
#pragma unroll
        for (int i = 0; i < 2; ++i) { const int o = tid + 512 * i; float s = 0.f;
#pragma unroll
            for (int w = 0; w < 8; ++w) s += part[w * 1024 + o];
            G[o] = s; }
        __syncthreads();
        const int ch = tid; float w[GRANK];
#pragma unroll
        for (int r = 0; r < GRANK; ++r) w[r] = wgu[r * GHK + ch];
        const float bias = bg[ch]; float run = 0.f;
        for (int t = 0; t < CH; ++t) {
            float z = bias;
#pragma unroll
            for (int r4 = 0; r4 < 4; ++r4) { const f32x4v g = *(const LAS f32x4v*)(G + t * 16 + r4 * 4); z += g[0] * w[4 * r4] + g[1] * w[4 * r4 + 1] + g[2] * w[4 * r4 + 2] + g[3] * w[4 * r4 + 3]; }
            run += (fminf(z, 0.f) - __builtin_amdgcn_logf(1.f + __builtin_amdgcn_exp2f(-fabsf(z) * 1.4426950408889634f)) * 0.69314718055994531f) * (1.f / 16.f);
            L[(m0 + t) * GHK + ch] = run;
        }
        DEC[(size_t)cn * GHK + ch] = expf(run);
        __syncthreads();
    }
}
}

namespace gla {
typedef short s16x4 __attribute__((ext_vector_type(4)));
typedef float f32x16 __attribute__((ext_vector_type(16)));
typedef unsigned u32x4 __attribute__((ext_vector_type(4)));
typedef unsigned u32x2 __attribute__((ext_vector_type(2)));
__device__ __forceinline__ unsigned cvtpk(float lo, float hi) { typedef float f2 __attribute__((ext_vector_type(2))); typedef __bf16 b2 __attribute__((ext_vector_type(2))); f2 v = {lo, hi}; b2 b = __builtin_convertvector(v, b2); return __builtin_bit_cast(unsigned, b); }
__device__ __forceinline__ float half_sum(float v) { auto rr = __builtin_amdgcn_permlane32_swap(__float_as_uint(v), __float_as_uint(v), false, false); return __uint_as_float(rr[0]) + __uint_as_float(rr[1]); }
__device__ __forceinline__ bf16x8 trfrag(LAS unsigned char* p0, LAS unsigned char* p1) {
    const s16x4 lo = __builtin_bit_cast(s16x4, __builtin_amdgcn_ds_read_tr16_b64_v4i16((LAS s16x4*)p0)), hh = __builtin_bit_cast(s16x4, __builtin_amdgcn_ds_read_tr16_b64_v4i16((LAS s16x4*)p1));
    return (bf16x8){lo[0], lo[1], lo[2], lo[3], hh[0], hh[1], hh[2], hh[3]};
}
constexpr int QRS = 272, VRS2 = 576;
constexpr int QT_BYTES = 64 * QRS, OFF_QP = 0, OFF_QN = QT_BYTES, OFF_KP = 2 * QT_BYTES, OFF_KN = 3 * QT_BYTES, OFF_V = 4 * QT_BYTES, OFF_SSQ = OFF_V + 64 * VRS2;
__device__ __forceinline__ void out_phase(LAS unsigned char* lds, const bf16_t* __restrict__ proj, const bf16_t* __restrict__ ST, const float* __restrict__ ng, bf16_t* __restrict__ og, int bid, int nblk, int tid) {
    const int lane = tid & 63, wave = __builtin_amdgcn_readfirstlane(tid >> 6), r32 = lane & 31, hi = lane >> 5;
    LAS float* SSQ = (LAS float*)(lds + OFF_SSQ);
    const unsigned qa = r32 * QRS + hi * 16;
    const unsigned va = OFF_V + (4 * hi + ((lane & 15) >> 2)) * VRS2 + (wave * 32 + 16 * ((lane >> 4) & 1) + 4 * (lane & 3)) * 2;
    for (int u = bid; u < NB * GH * NCH; u += nblk) {
        const int n = u % NCH, h = (u / NCH) % GH, b = u / (NCH * GH);
        const size_t m0 = (size_t)b * S + (size_t)n * CH;
        { u32x4 st[12];
#pragma unroll
          for (int i = 0; i < 8; ++i) { const int idx = tid + 512 * i, tile = idx >> 10, row = (idx >> 4) & 63, ch = idx & 15; st[i] = *(const u32x4*)(proj + (m0 + row) * 4096 + tile * 512 + h * GDK + ch * 8); }
#pragma unroll
          for (int i = 0; i < 4; ++i) { const int idx = tid + 512 * i, row = idx >> 5, ch = idx & 31; st[8 + i] = *(const u32x4*)(proj + (m0 + row) * 4096 + 2048 + h * GDV + ch * 8); }
#pragma unroll
          for (int i = 0; i < 8; ++i) { const int idx = tid + 512 * i, tile = idx >> 10, row = (idx >> 4) & 63, ch = idx & 15; *(LAS u32x4*)(lds + tile * QT_BYTES + row * QRS + ch * 16) = st[i]; }
#pragma unroll
          for (int i = 0; i < 4; ++i) { const int idx = tid + 512 * i, row = idx >> 5, ch = idx & 31; *(LAS u32x4*)(lds + OFF_V + row * VRS2 + ch * 16) = st[8 + i]; } }
        bf16x8 sf[8];
        { const bf16_t* sp = ST + ((size_t)u * GDV + wave * 32 + r32) * GDK + 8 * hi;
#pragma unroll
          for (int ks = 0; ks < 8; ++ks) sf[ks] = *(const bf16x8*)(sp + 16 * ks); }
        __syncthreads();
        f32x16 O[2];
#pragma unroll
        for (int tt = 0; tt < 2; ++tt) {
            bf16x8 qp[8], qn[8];
#pragma unroll
            for (int ks = 0; ks < 8; ++ks) { qp[ks] = *(const LAS bf16x8*)(lds + OFF_QP + tt * 32 * QRS + qa + ks * 32); qn[ks] = *(const LAS bf16x8*)(lds + OFF_QN + tt * 32 * QRS + qa + ks * 32); }
            u32x4 pf[4];
#pragma unroll
            for (int st_ = 0; st_ < 2; ++st_) {
                f32x16 p1, p2;
#pragma unroll
                for (int r = 0; r < 16; ++r) { p1[r] = 0.f; p2[r] = 0.f; }
                if (st_ <= tt) {
#pragma unroll
                    for (int ks = 0; ks < 8; ++ks) p1 = __builtin_amdgcn_mfma_f32_32x32x16_bf16(*(const LAS bf16x8*)(lds + OFF_KN + st_ * 32 * QRS + qa + ks * 32), qp[ks], p1, 0, 0, 0);
                }
                if (st_ >= tt) {
#pragma unroll
                    for (int ks = 0; ks < 8; ++ks) p2 = __builtin_amdgcn_mfma_f32_32x32x16_bf16(*(const LAS bf16x8*)(lds + OFF_KP + st_ * 32 * QRS + qa + ks * 32), qn[ks], p2, 0, 0, 0);
                }
                if (st_ == tt) {
#pragma unroll
                    for (int r = 0; r < 16; ++r) { const int srow = (r & 3) + 8 * (r >> 2) + 4 * hi; p1[r] = (r32 >= srow) ? p1[r] : p2[r]; }
                } else if (st_ > tt) p1 = p2;
#pragma unroll
                for (int s2 = 0; s2 < 2; ++s2) pf[st_ * 2 + s2] = (u32x4){cvtpk(p1[8 * s2], p1[8 * s2 + 1]), cvtpk(p1[8 * s2 + 2], p1[8 * s2 + 3]), cvtpk(p1[8 * s2 + 4], p1[8 * s2 + 5]), cvtpk(p1[8 * s2 + 6], p1[8 * s2 + 7])};
            }
            f32x16 o;
#pragma unroll
            for (int r = 0; r < 16; ++r) o[r] = 0.f;
#pragma unroll
            for (int f = 0; f < 4; ++f) o = __builtin_amdgcn_mfma_f32_32x32x16_bf16(trfrag(lds + va + (16 * f) * VRS2, lds + va + (16 * f + 8) * VRS2), __builtin_bit_cast(bf16x8, pf[f]), o, 0, 0, 0);
#pragma unroll
            for (int ks = 0; ks < 8; ++ks) o = __builtin_amdgcn_mfma_f32_32x32x16_bf16(sf[ks], qp[ks], o, 0, 0, 0);
            O[tt] = o;
            float ss = 0.f;
#pragma unroll
            for (int r = 0; r < 16; ++r) ss += o[r] * o[r];
            ss = half_sum(ss);
            if (hi == 0) SSQ[wave * 64 + tt * 32 + r32] = ss;
        }
        __syncthreads();
#pragma unroll
        for (int tt = 0; tt < 2; ++tt) {
            float tot = 0.f;
#pragma unroll
            for (int w = 0; w < 8; ++w) tot += SSQ[w * 64 + tt * 32 + r32];
            const float rstd = rsqrtf(tot * (1.f / GDV) + RMS_EPS);
            const size_t m = m0 + tt * 32 + r32;
#pragma unroll
            for (int g = 0; g < 4; ++g) { const int dv0 = wave * 32 + 8 * g + 4 * hi;
                const u32x2 rw = *(const u32x2*)(proj + m * 4096 + 3072 + h * GDV + dv0); const f32x4v gg = *(const f32x4v*)(ng + dv0);
                const float r0 = __uint_as_float(rw.x << 16), r1 = __uint_as_float(rw.x & 0xffff0000u), r2 = __uint_as_float(rw.y << 16), r3 = __uint_as_float(rw.y & 0xffff0000u);
                const float o0 = O[tt][4 * g] * rstd * gg[0] * (r0 / (1.f + __expf(-r0))), o1 = O[tt][4 * g + 1] * rstd * gg[1] * (r1 / (1.f + __expf(-r1)));
                const float o2 = O[tt][4 * g + 2] * rstd * gg[2] * (r2 / (1.f + __expf(-r2))), o3 = O[tt][4 * g + 3] * rstd * gg[3] * (r3 / (1.f + __expf(-r3)));
                u32x2 w; w.x = cvtpk(o0, o1); w.y = cvtpk(o2, o3); *(u32x2*)(og + m * GHV + h * GDV + dv0) = w; }
        }
        __syncthreads();
    }
}
}

namespace gla {
constexpr int SK_RS = 320, SV_RS = 64, SK_BYTES = 64 * SK_RS, SBUF = SK_BYTES + 64 * SV_RS;
__device__ __forceinline__ void state_phase(LAS unsigned char* lds, const bf16_t* __restrict__ proj, const float* __restrict__ DEC, bf16_t* __restrict__ ST, int bid, int nblk, int tid) {
    const int lane = tid & 63, wave = __builtin_amdgcn_readfirstlane(tid >> 6), r32 = lane & 31, hi = lane >> 5, i16 = lane & 15, g1 = (lane >> 4) & 1;
    for (int u = bid; u < NB * GH * 8; u += nblk) {
        const int dvs = u & 7, h = (u >> 3) & 3, b = u >> 5;
        const size_t mb = (size_t)b * S;
        const int krow = tid >> 4, kch = tid & 15, vrow = (tid >> 2) & 63, vch = tid & 3;
        const bf16_t* gk = proj + (mb + krow) * 4096 + 1536 + h * GDK + kch * 8;
        const bf16_t* gv = proj + (mb + vrow) * 4096 + 2048 + h * GDV + dvs * 32 + vch * 8;
        u32x4 st[3];
#define ST_ISSUE(n) do { st[0] = *(const u32x4*)(gk + (size_t)(n) * 64 * 4096); st[1] = *(const u32x4*)(gk + ((size_t)(n) * 64 + 32) * 4096); if (wave < 4) st[2] = *(const u32x4*)(gv + (size_t)(n) * 64 * 4096); } while (0)
#define ST_COMMIT(buf) do { LAS unsigned char* b_ = lds + (buf) * SBUF; *(LAS u32x4*)(b_ + krow * SK_RS + kch * 16) = st[0]; *(LAS u32x4*)(b_ + (krow + 32) * SK_RS + kch * 16) = st[1]; \
        if (wave < 4) *(LAS u32x4*)(b_ + SK_BYTES + vrow * SV_RS + vch * 16) = st[2]; } while (0)
        const unsigned aoff = SK_BYTES + (8 * hi + (i16 >> 2)) * SV_RS + (16 * g1 + 4 * (i16 & 3)) * 2;
        const unsigned boff = (8 * hi + (i16 >> 2)) * SK_RS + ((wave & 3) * 32 + 16 * g1 + 4 * (i16 & 3)) * 2;
        const float* dp = DEC + (size_t)b * NCH * GHK + h * GDK + (wave & 3) * 32 + r32;
        bf16_t* sp = ST + ((size_t)(b * GH + h) * NCH * GDV + dvs * 32 + 4 * hi) * GDK + (wave & 3) * 32 + r32;
        f32x16 acc;
#pragma unroll
        for (int r = 0; r < 16; ++r) acc[r] = 0.f;
        float dnext = dp[0];
        ST_ISSUE(0); ST_COMMIT(0); ST_ISSUE(1);
        __syncthreads();
        for (int n = 0; n < NCH; ++n) {
            const int buf = n & 1;
            if (n + 1 < NCH) ST_COMMIT(buf ^ 1);
            if (n + 2 < NCH) ST_ISSUE(n + 2);
            if (wave < 4) {
                const float dcur = dnext; if (n + 1 < NCH) dnext = dp[(size_t)(n + 1) * GHK];
                bf16_t* o = sp + (size_t)n * GDV * GDK;
#pragma unroll
                for (int r = 0; r < 16; ++r) o[(size_t)((r & 3) + 8 * (r >> 2)) * GDK] = (bf16_t)f2bf(acc[r]);
                LAS unsigned char* bb = lds + buf * SBUF;
#pragma unroll
                for (int ks = 0; ks < 4; ++ks) {
                    const bf16x8 af = trfrag(bb + aoff + (16 * ks) * SV_RS, bb + aoff + (16 * ks + 4) * SV_RS);
                    const bf16x8 bf = trfrag(bb + boff + (16 * ks) * SK_RS, bb + boff + (16 * ks + 4) * SK_RS);
                    acc = __builtin_amdgcn_mfma_f32_32x32x16_bf16(af, bf, acc, 0, 0, 0);
                }
#pragma unroll
                for (int r = 0; r < 16; ++r) acc[r] *= dcur;
            }
            __syncthreads();
        }
#undef ST_ISSUE
#undef ST_COMMIT
    }
}
}

#define RLX_AGENT __ATOMIC_RELAXED, __HIP_MEMORY_SCOPE_AGENT
#define XB_TMO      128
#define XB_XCNT(j)  (256  + 64 * (j))
#define XB_XSUB(j)  (1280 + 64 * (j))
#define XB_XGEN(j)  (2304 + 64 * (j))
#define XB_TOP      3328
#define XB_TOPGEN   3392
#define XCD_BAR_WORDS 3456
#define XB_SPIN_CAP (1u << 18)

__device__ __forceinline__ unsigned xb_ld(unsigned* p)              { return __hip_atomic_load(p, __ATOMIC_RELAXED, __HIP_MEMORY_SCOPE_AGENT); }
__device__ __forceinline__ unsigned xb_add(unsigned* p, unsigned v) { return __hip_atomic_fetch_add(p, v, __ATOMIC_RELAXED, __HIP_MEMORY_SCOPE_AGENT); }
__device__ __forceinline__ unsigned xb_xcc_id() { return (unsigned)__builtin_amdgcn_s_getreg((3 << 11) | 20) & 0xFu; }
#define XB_SPIN(cond, bar) do { unsigned _sp = 0; while (cond) { __builtin_amdgcn_s_sleep(1); \
    if ((++_sp & 255u) == 0u) { if (xb_ld(&(bar)[XB_TMO])) break; if (_sp > XB_SPIN_CAP) { atomicAdd(&(bar)[XB_TMO], 1u); break; } } } } while (0)

struct XcdBarrier {
    unsigned* bar; unsigned x;
    volatile LAS unsigned* st;
};

__device__ __forceinline__ XcdBarrier xcd_barrier_post(unsigned* bar, volatile LAS unsigned* st) {
    XcdBarrier b; b.bar = bar; b.x = xb_xcc_id(); b.st = st;
    if (threadIdx.x == 0) (void)xb_add(&bar[XB_XCNT(b.x)], 1u);
    return b;
}
__device__ __forceinline__ void xcd_barrier_complete(unsigned* bar, unsigned x, unsigned& nloc, unsigned& nx) {
    const unsigned G = gridDim.x * gridDim.y * gridDim.z;
    unsigned sum, cnt, mine, sp = 0u;
    for (;;) {
        sum = 0u; cnt = 0u; mine = 0u;
#pragma unroll
        for (unsigned j = 0; j < 16; ++j) { const unsigned c = xb_ld(&bar[XB_XCNT(j)]); sum += c; cnt += (c > 0u) ? 1u : 0u; mine = (j == x) ? c : mine; }
        if (sum == G) break;
        __builtin_amdgcn_s_sleep(1);
        if ((++sp & 255u) == 0u) { if (xb_ld(&bar[XB_TMO])) break; if (sp > XB_SPIN_CAP) { atomicAdd(&bar[XB_TMO], 1u); break; } }
    }
    nloc = mine > 0u ? mine : 1u; nx = cnt > 0u ? cnt : 1u;
}

__device__ __forceinline__ void xcd_barrier(const XcdBarrier& b) {
    asm volatile("s_waitcnt vmcnt(0)" ::: "memory");
    __syncthreads();
    if (threadIdx.x == 0) {
        unsigned* bar = b.bar;
        __builtin_amdgcn_s_waitcnt(0);
        unsigned nloc = b.st[0], nx = b.st[1];
        if (nloc == 0u) { xcd_barrier_complete(bar, b.x, nloc, nx); b.st[0] = nloc; b.st[1] = nx; }
        const unsigned old = xb_add(&bar[XB_XSUB(b.x)], 1u);
        const unsigned gen = old / nloc;
        if (old + 1u == (gen + 1u) * nloc) {
            __builtin_amdgcn_fence(__ATOMIC_RELEASE, "agent");
            asm volatile("s_waitcnt vmcnt(0)" ::: "memory");
            const unsigned og = xb_add(&bar[XB_TOP], 1u);
            const unsigned tg = og / nx;
            if (og + 1u == (tg + 1u) * nx) xb_add(&bar[XB_TOPGEN], 1u);
            else XB_SPIN(xb_ld(&bar[XB_TOPGEN]) == tg, bar);
            __builtin_amdgcn_fence(__ATOMIC_ACQUIRE, "agent");
            xb_add(&bar[XB_XGEN(b.x)], 1u);
            asm volatile("s_waitcnt vmcnt(0)" ::: "memory");
        } else {
            XB_SPIN(xb_ld(&bar[XB_XGEN(b.x)]) == gen, bar);
            __builtin_amdgcn_fence(__ATOMIC_ACQUIRE, "agent");
            asm volatile("s_waitcnt vmcnt(0)" ::: "memory");
        }
    }
    __syncthreads();
}

typedef float f32x4 __attribute__((ext_vector_type(4)));
typedef unsigned v4u __attribute__((ext_vector_type(4)));
typedef unsigned v2u __attribute__((ext_vector_type(2)));
constexpr int NWAVES = 8, NTHREADS = 512;
constexpr int LDS_BYTES = 147456, MISC_OFF = 131072 + 320, CW_BAR = 4096;
constexpr size_t MiB = 1u << 20;
constexpr size_t WS_CTL = 0, WS_CS = 1 * MiB, WS_WSET0 = 5 * MiB, WS_WSET1 = 32 * MiB, WS_B0 = 59 * MiB, WS_B1 = 91 * MiB, WS_BIG = 123 * MiB, WS_AUX = 251 * MiB, WS_PP = 299 * MiB, WS_GLR = 331 * MiB, WS_END = 332 * MiB;
constexpr size_t WO_IN = 0, WO_UQ = 786432, WO_UKV = 1179648, WO_OUT = 3145728, WO_W1 = 4194304, WO_W2 = 8388608, WO_G = 12582912, WO_P = 13631488, WO_LR = 13893632, WO_END = 13910016;
static_assert(WO_END * 2 <= 27 * MiB, "weight set fits its 27 MiB");

struct Args { const void* in[23]; float* out; unsigned char* ws; };

__device__ __forceinline__ const void* karg(int k) { const __attribute__((address_space(4))) unsigned long long* p = (const __attribute__((address_space(4))) unsigned long long*)__builtin_amdgcn_kernarg_segment_ptr(); asm volatile("" : "+s"(p)); return (const void*)p[k]; }
#define KIN(k) karg(k)
#define KOUT ((float*)karg(23))
#define KWS ((unsigned char*)karg(24))
struct Ctx { int tid, lane, wave, gw, ngw, bid, nblk; LAS unsigned char* lds; };

__device__ __forceinline__ void tr_item(const Ctx& c, const float* W, int ldw, int K, int N, bf16_t* WT, int it) {
    LAS float* scr = (LAS float*)(c.lds + c.wave * 16384);
    const int nblk = N / 32, lane = c.lane;
    const int kb = it / nblk, nb = it % nblk, k0 = 64 * kb, n0 = 32 * nb;
    float v[32];
#pragma unroll
    for (int i = 0; i < 32; ++i) v[i] = W[(size_t)(k0 + 2 * i + (lane >> 5)) * ldw + n0 + (lane & 31)];
#pragma unroll
    for (int i = 0; i < 32; ++i) scr[(2 * i + (lane >> 5)) * 33 + (lane & 31)] = v[i];
    asm volatile("s_waitcnt lgkmcnt(0)" ::: "memory");
    const int ch = lane & 7;
#pragma unroll
    for (int j = 0; j < 4; ++j) { const int n = (lane >> 3) + 8 * j; const LAS float* s = scr + (8 * ch) * 33 + n;
        v4u o; o.x = pk2(s[0 * 33], s[1 * 33]); o.y = pk2(s[2 * 33], s[3 * 33]); o.z = pk2(s[4 * 33], s[5 * 33]); o.w = pk2(s[6 * 33], s[7 * 33]);
        *(v4u*)(WT + (size_t)(n0 + n) * K + k0 + 8 * ch) = o; }
    asm volatile("s_waitcnt lgkmcnt(0)" ::: "memory");
}
__device__ __forceinline__ void convert_weights(const Ctx& c, const Args& a, int i, bf16_t* WS) {
    const int j = i / 3, kind = i % 3;
    const float* Wa; int lda_, Ka, Na; const float* Wb = nullptr; int ldb_ = 0, Kb = 64, Nb = 0; const float* Wc = nullptr; int ldc_ = 0, Kc = 64, Nc = 0; const float* Wo;
    if (kind == 0) { Wa = (const float*)KIN(3) + (size_t)j * D * GLA_IN; lda_ = GLA_IN; Ka = D; Na = 3072; Wo = (const float*)KIN(7) + (size_t)j * GHV * D; }
    else if (kind == 1) { Wa = (const float*)KIN(8) + (size_t)j * D * MLA_IN; lda_ = MLA_IN; Ka = D; Na = MLA_IN; Wb = (const float*)KIN(11) + (size_t)j * 256 * 1536; ldb_ = 1536; Kb = 256; Nb = 1536;
        Wc = (const float*)KIN(12) + (size_t)j * 256 * 2048; ldc_ = 2048; Kc = 256; Nc = 2048; Wo = (const float*)KIN(13) + (size_t)j * D * D; }
    else { Wa = (const float*)KIN(14) + (size_t)j * D * 3 * D; lda_ = 3 * D; Ka = D; Na = 3 * D; Wo = (const float*)KIN(16) + (size_t)j * D * D; }
    const int na = (Ka / 64) * (Na / 32), nb_ = (Kb / 64) * (Nb / 32), nc = (Kc / 64) * (Nc / 32), no = (D / 64) * (D / 32), n1 = (D / 64) * (FF / 32), n2 = (FF / 64) * (D / 32), ng = no, np = (PLE / 64) * (D / 32);
    const int total = na + nb_ + nc + no + n1 + n2 + ng + np;
    for (int it = c.gw; it < total; it += c.ngw) {
        int r = it; const float* W; int ldw, K, N; bf16_t* WT;
        if (r < n1) { W = (const float*)KIN(19) + (size_t)i * D * FF; ldw = FF; K = D; N = FF; WT = WS + WO_W1; }
        else if ((r -= n1) < n2) { W = (const float*)KIN(20) + (size_t)i * FF * D; ldw = D; K = FF; N = D; WT = WS + WO_W2; }
        else if ((r -= n2) < na) { W = Wa; ldw = lda_; K = Ka; N = Na; WT = WS + WO_IN; }
        else if ((r -= na) < no) { W = Wo; ldw = D; K = D; N = D; WT = WS + WO_OUT; }
        else if ((r -= no) < ng) { W = (const float*)KIN(21) + (size_t)i * D * D; ldw = D; K = D; N = D; WT = WS + WO_G; }
        else if ((r -= ng) < np) { W = (const float*)KIN(22) + (size_t)i * PLE * D; ldw = D; K = PLE; N = D; WT = WS + WO_P; }
        else if ((r -= np) < nb_) { W = Wb; ldw = ldb_; K = Kb; N = Nb; WT = WS + WO_UQ; }
        else { r -= nb_; W = Wc; ldw = ldc_; K = Kc; N = Nc; WT = WS + WO_UKV; }
        tr_item(c, W, ldw, K, N, WT, r);
    }
    if (kind == 0) { const float* Wl = (const float*)KIN(3) + (size_t)j * D * GLA_IN + 3072;
        for (int e = c.bid * NTHREADS + c.tid; e < D * GRANK; e += c.nblk * NTHREADS) { const int k = e >> 4, n = e & 15; WS[WO_LR + (size_t)n * D + k] = (bf16_t)f2bf(Wl[(size_t)k * GLA_IN + n]); } }
    if (kind == 1) { unsigned zz = 0u; asm volatile("" : "+v"(zz));
        for (size_t e = (size_t)c.bid * NTHREADS + c.tid; e < (size_t)(MLA_INP - MLA_IN) * D / 8; e += (size_t)c.nblk * NTHREADS) *((v4u*)(WS + WO_IN + (size_t)MLA_IN * D) + e) = (v4u){zz, zz, zz, zz}; }
}
__device__ __forceinline__ void cvt_rows(const Ctx& c, const float* src, bf16_t* dst, size_t n) {
    const size_t stride = (size_t)c.nblk * NTHREADS;
    for (size_t e = (size_t)c.bid * NTHREADS + c.tid; e < n / 4; e += 4 * stride) {
        f32x4 v[4];
#pragma unroll
        for (int k = 0; k < 4; ++k) if (e + k * stride < n / 4) v[k] = ((const f32x4*)src)[e + k * stride];
#pragma unroll
        for (int k = 0; k < 4; ++k) if (e + k * stride < n / 4) { v2u o; o.x = pk2(v[k].x, v[k].y); o.y = pk2(v[k].z, v[k].w); ((v2u*)dst)[e + k * stride] = o; }
    }
}
__device__ __forceinline__ void ln_pass(const Ctx& c, float* X, const float* g, const float* b, bf16_t* xb) {
    for (int m = c.gw; m < M; m += c.ngw) {
        f32x4* xr = (f32x4*)(X + (size_t)m * D) + c.lane;
        f32x4 v[4]; float s = 0.f;
#pragma unroll
        for (int j = 0; j < 4; ++j) { v[j] = xr[64 * j]; s += (v[j].x + v[j].y) + (v[j].z + v[j].w); }
        const float mean = wave_sum(s) * (1.f / D); float s2 = 0.f;
#pragma unroll
        for (int j = 0; j < 4; ++j) { v[j] = v[j] - mean; s2 += (v[j].x * v[j].x + v[j].y * v[j].y) + (v[j].z * v[j].z + v[j].w * v[j].w); }
        const float rstd = 1.f / sqrtf(wave_sum(s2) * (1.f / D) + LN_EPS);
        v2u* o8 = (v2u*)(xb + (size_t)m * D) + c.lane;
#pragma unroll
        for (int j = 0; j < 4; ++j) { const f32x4 gg = ((const f32x4*)g)[c.lane + 64 * j], bb = ((const f32x4*)b)[c.lane + 64 * j]; const f32x4 o = v[j] * rstd * gg + bb;
            xr[64 * j] = o; v2u w; w.x = pk2(o.x, o.y); w.y = pk2(o.z, o.w); o8[64 * j] = w; }
    }
}


enum { T_NOP = 0, T_PROLOGUE, T_GEMM_BF16, T_GEMM_RELU2, T_GEMM_RES, T_GEMM_PLE, T_GLA_LUNIT, T_GLA_STATE, T_GLA_OUT, T_GEMM_GLA, T_MLA_PREP, T_MLA_QROPE, T_MLA_ATTN, T_CONVMIX, T_LN, T_PCVT, T_WCVT };
struct Op { int type, sync, n0, n1; const void *a0, *a1, *a2, *a3, *a4; void *o0, *o1, *o2; };

__device__ __forceinline__ int n_mixer_steps(int kind) { return kind == 2 ? 2 : (kind == 1 ? 6 : 4); }
__device__ __forceinline__ void decode(const Args& a, int i, int s, Op& op) {
    unsigned char* ws = KWS;
    const int j = i / 3, kind = i % 3, nm = n_mixer_steps(kind);
    bf16_t* W = (bf16_t*)(ws + ((i & 1) ? WS_WSET1 : WS_WSET0));
    bf16_t* B0 = (bf16_t*)(ws + WS_B0); bf16_t* B1 = (bf16_t*)(ws + WS_B1); bf16_t* BIG = (bf16_t*)(ws + WS_BIG); bf16_t* AUX = (bf16_t*)(ws + WS_AUX); bf16_t* PP = (bf16_t*)(ws + WS_PP);
    float* XR = KOUT; float* CS = (float*)(ws + WS_CS); float* GLR = (float*)(ws + WS_GLR);
    op.type = T_NOP; op.sync = 1; op.n0 = 0; op.n1 = 0; op.a0 = op.a1 = op.a2 = op.a3 = op.a4 = nullptr; op.o0 = op.o1 = op.o2 = nullptr;
    if (s < nm) {
        if (kind == 0) {
            bf16_t* PROJ = BIG; float* L = (float*)(ws + WS_B1); bf16_t* ST = AUX; float* DEC = GLR;
            switch (s) {
            case 0: op.type = T_GLA_LUNIT; op.a0 = B0; op.a1 = W + WO_LR; op.a2 = (const float*)KIN(4) + (size_t)j * GRANK * GHK; op.a3 = (const float*)KIN(5) + (size_t)j * GHK; op.o0 = L; op.o1 = DEC; break;
            case 1: op.type = T_GEMM_GLA; op.a0 = B0; op.a1 = W + WO_IN; op.n0 = 3072; op.n1 = D; op.o0 = PROJ; op.a2 = L; break;
            case 2: op.type = T_GLA_STATE; op.a0 = PROJ; op.a1 = DEC; op.o0 = ST; break;
            default: op.type = T_GLA_OUT; op.a0 = PROJ; op.a1 = ST; op.a2 = (const float*)KIN(6) + (size_t)j * GDV; op.o0 = B1; break;
            }
        } else if (kind == 1) {
            bf16_t* Cb = AUX; bf16_t* cqn = AUX + (size_t)12 * MiB; bf16_t* ckvn = AUX + (size_t)16 * MiB; bf16_t* kr = AUX + (size_t)20 * MiB;
            bf16_t* q = BIG; bf16_t* kv = BIG + (size_t)24 * MiB;
            switch (s) {
            case 0: op.type = T_GEMM_BF16; op.a0 = B0; op.a1 = W + WO_IN; op.n0 = MLA_INP; op.n1 = D; op.o0 = Cb; break;
            case 1: op.type = T_MLA_PREP; op.a0 = Cb; op.a1 = (const float*)KIN(9) + j * 256; op.a2 = (const float*)KIN(10) + j * 256; op.a3 = CS; op.o0 = cqn; op.o1 = ckvn; op.o2 = kr; break;
            case 2: op.type = T_GEMM_BF16; op.sync = 0; op.a0 = cqn; op.a1 = W + WO_UQ; op.n0 = 1536; op.n1 = 256; op.o0 = q; break;
            case 3: op.type = T_GEMM_BF16; op.a0 = ckvn; op.a1 = W + WO_UKV; op.n0 = 2048; op.n1 = 256; op.o0 = kv; break;
            case 4: op.type = T_MLA_QROPE; op.a0 = CS; op.o0 = q; break;
            default: op.type = T_MLA_ATTN; op.a0 = q; op.a1 = kv; op.a2 = kr; op.o0 = B1; break;
            }
        } else {
            if (s == 0) { op.type = T_GEMM_BF16; op.a0 = B0; op.a1 = W + WO_IN; op.n0 = 3 * D; op.n1 = D; op.o0 = BIG; }
            else { op.type = T_CONVMIX; op.a0 = BIG; op.a1 = (const float*)KIN(15) + (size_t)j * 3 * D; op.o0 = B1; }
        }
    } else {
        switch (s - nm) {
        case 0: op.type = T_GEMM_RES; op.a0 = B1; op.a1 = W + WO_OUT; op.n0 = D; op.n1 = D; op.a2 = (i == 0) ? (const float*)KIN(0) : XR; op.o0 = XR; break;
        case 1: op.type = T_LN; op.sync = 0; op.a0 = (const float*)KIN(17) + (size_t)(2 * i) * D; op.a1 = (const float*)KIN(18) + (size_t)(2 * i) * D; op.o0 = XR; op.o1 = B0; break;
        case 2: op.type = T_PCVT; op.sync = 0; op.a0 = (const float*)KIN(1) + (size_t)i * M * PLE; op.o0 = AUX; break;
        case 3: op.type = (i + 1 < DEPTH) ? T_WCVT : T_NOP; op.n0 = i + 1; op.o0 = ws + (((i + 1) & 1) ? WS_WSET1 : WS_WSET0); break;
        case 4: op.type = T_GEMM_RELU2; op.sync = 0; op.a0 = B0; op.a1 = W + WO_W1; op.n0 = FF; op.n1 = D; op.o0 = BIG; break;
        case 5: op.type = T_GEMM_BF16; op.a0 = AUX; op.a1 = W + WO_P; op.n0 = D; op.n1 = PLE; op.o0 = PP; break;
        case 6: op.type = T_GEMM_RES; op.a0 = BIG; op.a1 = W + WO_W2; op.n0 = D; op.n1 = FF; op.a2 = XR; op.o0 = XR; break;
        case 7: op.type = T_LN; op.a0 = (const float*)KIN(17) + (size_t)(2 * i + 1) * D; op.a1 = (const float*)KIN(18) + (size_t)(2 * i + 1) * D; op.o0 = XR; op.o1 = B1; break;
        default: op.type = T_GEMM_PLE; op.sync = (i + 1 < DEPTH) ? 1 : 0; op.a0 = B1; op.a1 = W + WO_G; op.n0 = D; op.n1 = D; op.a2 = PP; op.o0 = XR; op.o1 = B0; break;
        }
    }
}

#define RUN_GEMM(EPI_T, ...) do { pg8::Gemm g_{(const bf16_t*)op.a0, (const bf16_t*)op.a1, M, op.n0, op.n1}; pg8::StaticOrder S_; S_.init(M, op.n0, c.nblk, c.bid); \
    EPI_T E_{__VA_ARGS__}; pg8::gemm_phase<EPI_T, pg8::StaticOrder, true, true>(c.lds, g_, S_, E_); } while (0)

__global__ void __launch_bounds__(NTHREADS, 2) mega_fwd(Args a) {
    extern __shared__ __attribute__((aligned(16))) unsigned char lds_raw[];
    cg::grid_group grid = cg::this_grid();
    { LAS unsigned* z = (LAS unsigned*)(lds_raw) + MISC_OFF / 4; if (threadIdx.x < 32) z[threadIdx.x] = 0u; }
    __syncthreads();
    (void)xcd_barrier_post((unsigned*)(KWS + WS_CTL) + CW_BAR, (volatile LAS unsigned*)((LAS unsigned char*)lds_raw + MISC_OFF) + 8);
    bool first_sync = true;
    for (int i = -1; i < DEPTH; ++i) {
        const int ns = (i < 0) ? 1 : n_mixer_steps(i % 3) + 9;
#ifndef PROBE_MASK
#define PROBE_MASK 0u
#endif
        for (int s2 = 0; s2 < ns * (PROBE_MASK ? 2 : 1); ++s2) {
            const int s = PROBE_MASK ? (s2 >> 1) : s2;
            Ctx c; c.tid = tid_now(); c.bid = bid_now(); c.lane = c.tid & 63; c.wave = __builtin_amdgcn_readfirstlane(c.tid >> 6); c.nblk = nblk_now(); c.gw = c.bid * NWAVES + c.wave; c.ngw = c.nblk * NWAVES; c.lds = (LAS unsigned char*)lds_raw;
            Op op;
            if (i < 0) { op.type = T_PROLOGUE; op.sync = 1; op.n0 = op.n1 = 0; op.a0 = op.a1 = op.a2 = op.a3 = op.a4 = nullptr; op.o0 = op.o1 = op.o2 = nullptr; }
            else decode(a, i, s, op);
            if (PROBE_MASK && (s2 & 1) && !((PROBE_MASK >> op.type) & 1u)) continue;
            switch (op.type) {
            case T_PROLOGUE: {
                const int* pos = (const int*)KIN(2); float* CS = (float*)(KWS + WS_CS);
                for (size_t e = (size_t)c.bid * NTHREADS + c.tid; e < (size_t)M * 32; e += (size_t)c.nblk * NTHREADS) {
                    const int jj = (int)(e & 31); const size_t m = e >> 5; const float ang = (float)pos[m] * inv_freq(jj);
                    float sn_, cs_; sincosf(ang, &sn_, &cs_); CS[m * 64 + jj] = cs_; CS[m * 64 + 32 + jj] = sn_;
                }
                cvt_rows(c, (const float*)KIN(0), (bf16_t*)(KWS + WS_B0), (size_t)M * D);
                convert_weights(c, a, 0, (bf16_t*)(KWS + WS_WSET0));
            } break;
            case T_GEMM_BF16: RUN_GEMM(pg8::EpiBf16<0>, (bf16_t*)op.o0, op.n0); break;
            case T_GEMM_RELU2: RUN_GEMM(pg8::EpiBf16<2>, (bf16_t*)op.o0, op.n0); break;
            case T_GEMM_RES: RUN_GEMM(pg8::EpiRes, (const float*)op.a2, (float*)op.o0, D, ALPHA); break;
            case T_GEMM_PLE: RUN_GEMM(pg8::EpiPle, (const float*)op.o0, (float*)op.o0, (const bf16_t*)op.a2, (bf16_t*)op.o1, D); break;
            case T_GLA_LUNIT: gla::l_units(c.lds, (const bf16_t*)op.a0, (const bf16_t*)op.a1, (const float*)op.a2, (const float*)op.a3, (float*)op.o0, (float*)op.o1, c.bid, c.nblk, c.tid); break;
            case T_GEMM_GLA: RUN_GEMM(pg8::EpiGla, (bf16_t*)op.o0, (const float*)op.a2); break;
            case T_GLA_STATE: gla::state_phase(c.lds, (const bf16_t*)op.a0, (const float*)op.a1, (bf16_t*)op.o0, c.bid, c.nblk, c.tid); break;
            case T_GLA_OUT: gla::out_phase(c.lds, (const bf16_t*)op.a0, (const bf16_t*)op.a1, (const float*)op.a2, (bf16_t*)op.o0, c.bid, c.nblk, c.tid); break;
            case T_MLA_PREP: mla_prep<bf16_t, bf16_t>((const bf16_t*)op.a0, MLA_INP, (const float*)op.a1, (const float*)op.a2, (const float*)op.a3, (bf16_t*)op.o0, (bf16_t*)op.o1, (bf16_t*)op.o2, M); break;
            case T_MLA_QROPE: mla_qrope<bf16_t>((bf16_t*)op.o0, (const float*)op.a0, M); break;
            case T_MLA_ATTN: mla::attn_phase(c.lds, (const bf16_t*)op.a0, (const bf16_t*)op.a1, (const bf16_t*)op.a2, (bf16_t*)op.o0, c.bid, c.nblk, c.tid); break;
            case T_CONVMIX: conv_mix_vec((const bf16_t*)op.a0, (const float*)op.a1, (bf16_t*)op.o0); break;
            case T_LN: ln_pass(c, (float*)op.o0, (const float*)op.a0, (const float*)op.a1, (bf16_t*)op.o1); break;
            case T_PCVT: cvt_rows(c, (const float*)op.a0, (bf16_t*)op.o0, (size_t)M * PLE); break;
            case T_WCVT: convert_weights(c, a, op.n0, (bf16_t*)op.o0); break;
            default: break;
            }
            if (op.sync) {
                if (first_sync) { grid.sync(); first_sync = false; }
                else { XcdBarrier bar; bar.bar = (unsigned*)(KWS + WS_CTL) + CW_BAR; bar.x = xb_xcc_id(); bar.st = (volatile LAS unsigned*)((LAS unsigned char*)lds_raw + MISC_OFF) + 8; xcd_barrier(bar); }
            }
        }
    }
}

extern "C" void kernel_launch(void* const* d_in, const int* in_sizes, int n_in, void* d_out, int out_size, void* d_ws, size_t ws_size, hipStream_t stream) {
    static int grid = 0;
    if (grid == 0) {
        if (n_in != 23 || out_size != M * D || ws_size < WS_END) { fprintf(stderr, "kernel_launch: unexpected shapes/workspace (n_in %d out %d ws %zu need %zu)\n", n_in, out_size, ws_size, (size_t)WS_END); grid = -1; return; }
        int dev = 0, cus = 0, per_cu = 0;
        (void)hipGetDevice(&dev); (void)hipDeviceGetAttribute(&cus, hipDeviceAttributeMultiprocessorCount, dev);
        if (hipFuncSetAttribute((const void*)mega_fwd, hipFuncAttributeMaxDynamicSharedMemorySize, LDS_BYTES) != hipSuccess) { fprintf(stderr, "kernel_launch: hipFuncSetAttribute failed\n"); grid = -1; return; }
        (void)hipOccupancyMaxActiveBlocksPerMultiprocessor(&per_cu, (const void*)mega_fwd, NTHREADS, LDS_BYTES);
        if (per_cu < 1) { fprintf(stderr, "kernel_launch: occupancy query says %d blocks per CU\n", per_cu); grid = -1; return; }
        grid = cus;
    }
    if (grid < 0) return;
    if (hipMemsetAsync((char*)d_ws + WS_CTL, 0, 65536, stream) != hipSuccess) { fprintf(stderr, "kernel_launch: hipMemsetAsync failed\n"); return; }
    Args a{};
    for (int i = 0; i < 23; ++i) a.in[i] = d_in[i];
    a.out = (float*)d_out; a.ws = (unsigned char*)d_ws;
    void* args[] = {&a};
    hipError_t e = hipLaunchCooperativeKernel((const void*)mega_fwd, dim3(grid), dim3(NTHREADS), args, LDS_BYTES, stream);
    if (e != hipSuccess) fprintf(stderr, "cooperative launch failed: %s (grid %d)\n", hipGetErrorString(e), grid);
}
```
